# Optimizing an MI355X kernel written in HIP

```python
import math
import jax, jax.numpy as jnp
from jax import lax
import numpy as np

D_MODEL = 1024
BATCH = 8
SEQ = 4096
DEPTH = 4

CHUNK = 64
N_MEM = 256
N_MIXERS = 2
SSM_GROUP = 16
SSM_GROUPS = D_MODEL // SSM_GROUP
SSM_STATE = 64
DT_MIN = 1e-3
DT_MAX = 1e-1
CONV_WIDTH = 3
XATTN_HEADS = 4
XATTN_HEAD_DIM = D_MODEL // XATTN_HEADS
MLP_HIDDEN = 4 * D_MODEL
N_SSM_LAYERS = (DEPTH + 1) // 2
N_CONV_LAYERS = DEPTH // 2
NORM_EPS = 1e-6

kernel_name = "hybrid_s5_shortconv_memxattn_trunk"


def _rms_norm(x, g):
    x32 = x.astype(jnp.float32)
    y = x32 * lax.rsqrt(jnp.mean(x32 * x32, axis=-1, keepdims=True) + NORM_EPS)
    return (y * g.astype(jnp.float32)).astype(x.dtype)


def _diag_combine(left, right):
    a1, b1 = left
    a2, b2 = right
    return a1 * a2, a2 * b1 + b2


def _s5_mixer(h, a_re, a_im, log_dt, b_re, b_im, c_re, c_im, d_skip, w_glu):
    bsz, seq, dm = h.shape
    n_chunks = seq // CHUNK
    f32 = jnp.float32
    u = h.astype(f32)
    lam = lax.complex(a_re.astype(f32), a_im.astype(f32))
    dt = jnp.exp(log_dt.astype(f32))[:, None]
    a_bar = jnp.exp(lam * dt)
    b = lax.complex(b_re.astype(f32), b_im.astype(f32))
    b_bar = ((a_bar - 1.0) / lam)[:, :, None] * b
    c = lax.complex(c_re.astype(f32), c_im.astype(f32))
    u_chunks = u.reshape(bsz, n_chunks, CHUNK, SSM_GROUPS, SSM_GROUP).transpose(1, 0, 2, 3, 4)
    a_seq = jnp.broadcast_to(a_bar, (CHUNK, bsz, SSM_GROUPS, SSM_STATE))

    def chunk_step(state, u_c):
        bu = jnp.einsum('bcgh,gph->cbgp', u_c.astype(jnp.complex64), b_bar)
        bu = bu.at[0].add(a_bar * state)
        _, states = lax.associative_scan(_diag_combine, (a_seq, bu), axis=0)
        y_c = jnp.einsum('cbgp,ghp->bcgh', states, c).real
        return states[-1], y_c

    state0 = jnp.zeros((bsz, SSM_GROUPS, SSM_STATE), jnp.complex64)
    _, ys = lax.scan(chunk_step, state0, u_chunks)
    y = ys.transpose(1, 0, 2, 3, 4).reshape(bsz, seq, dm) + d_skip.astype(f32) * u
    y = jax.nn.gelu(y).astype(h.dtype)
    val, gate = jnp.split(y @ w_glu, 2, axis=-1)
    return val * jax.nn.sigmoid(gate)


def _short_conv_mixer(h, w_in, conv_w, w_out):
    dm = h.shape[-1]
    gate_b, gate_c, v = jnp.split(h @ w_in, 3, axis=-1)
    z = gate_c * v
    z = lax.conv_general_dilated(
        z, conv_w[:, None, :].astype(z.dtype), window_strides=(1,),
        padding=[(CONV_WIDTH - 1, 0)], dimension_numbers=('NWC', 'WIO', 'NWC'),
        feature_group_count=dm)
    return (gate_b * z) @ w_out


def _memory_cross_attention(h, mem_n, w_q, w_kv, w_o):
    bsz, seq, dm = h.shape
    n_mem = mem_n.shape[1]
    q = (h @ w_q).reshape(bsz, seq, XATTN_HEADS, XATTN_HEAD_DIM)
    k, v = jnp.split(mem_n @ w_kv, 2, axis=-1)
    k = k.reshape(bsz, n_mem, XATTN_HEADS, XATTN_HEAD_DIM)
    v = v.reshape(bsz, n_mem, XATTN_HEADS, XATTN_HEAD_DIM)
    s = jnp.einsum('bqhd,bkhd->bhqk', q.astype(jnp.float32), k.astype(jnp.float32)) * (XATTN_HEAD_DIM ** -0.5)
    p = jax.nn.softmax(s, axis=-1)
    o = jnp.einsum('bhqk,bkhd->bqhd', p, v.astype(jnp.float32)).reshape(bsz, seq, dm)
    return o.astype(h.dtype) @ w_o


def _sqrelu_mlp(h, w1, w2):
    a = jax.nn.relu(h @ w1)
    return (a * a) @ w2


def setup_inputs(seed: int = 0) -> dict:
    key = jax.random.key(seed)
    ks = jax.random.split(key, 24)
    f32 = jnp.float32
    D, G, P, H = D_MODEL, SSM_GROUPS, SSM_STATE, SSM_GROUP
    Ls, Lc = N_SSM_LAYERS, N_CONV_LAYERS

    def nrm(k, shape, scale):
        return jax.random.normal(k, shape, f32) * scale

    def gain(k, shape):
        return 1.0 + 0.02 * jax.random.normal(k, shape, f32)

    a_im_base = jnp.pi * jnp.arange(P, dtype=f32)
    return {
        "x": jax.random.normal(ks[0], (BATCH, SEQ, D), f32),
        "mem": jax.random.normal(ks[1], (BATCH, N_MEM, D), f32),
        "mem_norm_g": gain(ks[2], (D,)),
        "mix_norm_g": gain(ks[3], (DEPTH, D)),
        "xattn_norm_g": gain(ks[4], (DEPTH, D)),
        "mlp_norm_g": gain(ks[5], (DEPTH, D)),
        "s5_a_re": -0.5 + 0.01 * jax.random.normal(ks[6], (Ls, G, P), f32),
        "s5_a_im": a_im_base + 0.01 * jax.random.normal(ks[7], (Ls, G, P), f32),
        "s5_log_dt": jax.random.uniform(ks[8], (Ls, G), f32, math.log(DT_MIN), math.log(DT_MAX)),
        "s5_b_re": nrm(ks[9], (Ls, G, P, H), (2.0 * H) ** -0.5),
        "s5_b_im": nrm(ks[10], (Ls, G, P, H), (2.0 * H) ** -0.5),
        "s5_c_re": nrm(ks[11], (Ls, G, H, P), P ** -0.5),
        "s5_c_im": nrm(ks[12], (Ls, G, H, P), P ** -0.5),
        "s5_d": nrm(ks[13], (Ls, D), 1.0),
        "s5_w_glu": nrm(ks[14], (Ls, D, 2 * D), D ** -0.5),
        "conv_w_in": nrm(ks[15], (Lc, D, 3 * D), D ** -0.5),
        "conv_w": nrm(ks[16], (Lc, CONV_WIDTH, D), CONV_WIDTH ** -0.5),
        "conv_w_out": nrm(ks[17], (Lc, D, D), D ** -0.5),
        "xa_w_q": nrm(ks[18], (DEPTH, D, D), D ** -0.5),
        "xa_w_kv": nrm(ks[19], (DEPTH, D, 2 * D), D ** -0.5),
        "xa_w_o": nrm(ks[20], (DEPTH, D, D), D ** -0.5),
        "mlp_w1": nrm(ks[21], (DEPTH, D, MLP_HIDDEN), D ** -0.5),
        "mlp_w2": nrm(ks[22], (DEPTH, MLP_HIDDEN, D), MLP_HIDDEN ** -0.5),
        "final_norm_g": gain(ks[23], (D,)),
    }


def reference(x, mem, mem_norm_g, mix_norm_g, xattn_norm_g, mlp_norm_g,
              s5_a_re, s5_a_im, s5_log_dt, s5_b_re, s5_b_im, s5_c_re, s5_c_im,
              s5_d, s5_w_glu, conv_w_in, conv_w, conv_w_out,
              xa_w_q, xa_w_kv, xa_w_o, mlp_w1, mlp_w2, final_norm_g):
    mem_n = _rms_norm(mem, mem_norm_g)
    for i in range(DEPTH):
        h = _rms_norm(x, mix_norm_g[i])
        j = i // N_MIXERS
        if i % N_MIXERS == 0:
            x = x + _s5_mixer(h, s5_a_re[j], s5_a_im[j], s5_log_dt[j], s5_b_re[j], s5_b_im[j],
                              s5_c_re[j], s5_c_im[j], s5_d[j], s5_w_glu[j])
        else:
            x = x + _short_conv_mixer(h, conv_w_in[j], conv_w[j], conv_w_out[j])
        x = x + _memory_cross_attention(_rms_norm(x, xattn_norm_g[i]), mem_n,
                                        xa_w_q[i], xa_w_kv[i], xa_w_o[i])
        x = x + _sqrelu_mlp(_rms_norm(x, mlp_norm_g[i]), mlp_w1[i], mlp_w2[i])
    return _rms_norm(x, final_norm_g)
```

```cpp
#include <hip/hip_runtime.h>
#include <hip/hip_cooperative_groups.h>
#include <cstdio>
#include <cstdint>
namespace cg = cooperative_groups;

namespace pg8 {
#define PG8_LAS __attribute__((address_space(3)))
typedef unsigned short bf16_t;
typedef short bf16x8 __attribute__((ext_vector_type(8)));
typedef float f32x4 __attribute__((ext_vector_type(4)));
typedef unsigned u32x4 __attribute__((ext_vector_type(4)));
typedef unsigned u32x2 __attribute__((ext_vector_type(2)));
constexpr int BM = 256, BK = 64, HALF = 128, HTB = HALF * BK * 2  , STAGE_BYTES = 8 * HTB, NXCD = 8, WGM = 8;

__host__ __device__ __forceinline__ int lds_byte(int r, int c) { const int st = (r >> 4) * 2 + (c >> 5), rr = r & 15, cc = c & 31, ob = rr * 64 + cc * 2; return st * 1024 + (ob ^ (((ob >> 9) & 1) << 5)); }
__host__ __device__ __forceinline__ void stage_rc(int b, int& R, int& C) { const int st = b / 1024, sb = b % 1024, swz = sb ^ (((sb >> 9) & 1) << 5); R = (st >> 1) * 16 + swz / 64; C = (st & 1) * 32 + (swz % 64) / 2; }
__host__ __device__ __forceinline__ int perm32(int rho) { const int n = rho >> 4, i = rho & 15; return 8 * (i >> 2) + 4 * n + (i & 3); }

struct Unit { int pm, pn; };

struct Order {
    int nM, nN, nwg, G, c; const char* A; const char* B; long am, an, bn, bb, bg;
    __device__ __forceinline__ bool next(int i, Unit& u) const {
        const long L = (long)i * G + c; if (L >= nwg) return false;
        int wgid = (int)L; { const int q = nwg / NXCD, r = nwg % NXCD, xcd = wgid % NXCD, off = wgid / NXCD; wgid = (xcd < r ? xcd * (q + 1) : r * (q + 1) + (xcd - r) * q) + off; }
        const int nig = WGM * nN, gid = wgid / nig, fm = gid * WGM, gsz = (nM - fm) < WGM ? (nM - fm) : WGM;
        u.pm = fm + ((wgid % nig) % gsz); u.pn = (wgid % nig) / gsz; return true;
    }
    __device__ __forceinline__ const char* abase(const Unit& u) const { return A + (long)u.pm * am + (long)u.pn * an; }
    __device__ __forceinline__ const char* bbase(const Unit& u) const { return B + (long)u.pn * bn + (long)(u.pm >> 4) * bb + (long)(u.pm & 63) * bg; }
};

__device__ __forceinline__ unsigned cvt_pk_bf16(float lo, float hi) { unsigned r; asm volatile("v_cvt_pk_bf16_f32 %0, %1, %2" : "=v"(r) : "v"(lo), "v"(hi)); return r; }
__device__ __forceinline__ u32x4 pack8(const f32x4 a, const f32x4 b) { u32x4 w; w.x = cvt_pk_bf16(a[0], a[1]); w.y = cvt_pk_bf16(a[2], a[3]); w.z = cvt_pk_bf16(b[0], b[1]); w.w = cvt_pk_bf16(b[2], b[3]); return w; }
__device__ __forceinline__ float bf_lo(unsigned w) { return __uint_as_float(w << 16); }
__device__ __forceinline__ float bf_hi(unsigned w) { return __uint_as_float(w & 0xffff0000u); }

enum { M_STORE = 0, M_SCALE, M_UP, M_CONVIN, M_RES, M_GLU, M_P, M_O, M_G, M_Y };
__device__ __forceinline__ float gelu_tanh(float y) {
    const float z = 0.7978845608f * (y + 0.044715f * y * y * y);
    const float e = __builtin_amdgcn_exp2f(z * 2.8853900818f);
    const float t = 1.0f - 2.0f * __builtin_amdgcn_rcpf(1.0f + e);
    return 0.5f * y * (1.0f + t);
}
struct Epi {
    static constexpr bool PERM = true;
    int mode, ldc; float mul;
    bf16_t* o0; bf16_t* o1; const float* f0; const float* f1; float* f2; const bf16_t* b0;
    const unsigned long long* sin; unsigned long long* sout;
    __device__ __forceinline__ void operator()(const f32x4 (&acc)[2][2][4][2], const Unit& u, int wr, int wc, int fr, int fq) const {
        const int r0 = u.pm * 256 + wr * 64 + fr;
        const int cw = wc * 32 + 8 * fq;
        if (mode == M_STORE || mode == M_SCALE || mode == M_UP) {
#pragma unroll
            for (int ai = 0; ai < 2; ++ai)
#pragma unroll
                for (int m = 0; m < 4; ++m) { const int row = r0 + ai * 128 + m * 16; float rs = 1.0f;
                    if (mode != M_STORE) rs = __builtin_amdgcn_rsqf((float)sin[row] * (1.0f / (1024.0f * 1048576.0f)) + 1e-6f) * mul;
                    bf16_t* rowp = o0 + (size_t)row * ldc + u.pn * 256 + cw;
#pragma unroll
                    for (int bj = 0; bj < 2; ++bj) { f32x4 v0 = acc[ai][bj][m][0] * rs, v1 = acc[ai][bj][m][1] * rs;
                        if (mode == M_UP) {
#pragma unroll
                            for (int j = 0; j < 4; ++j) { const float a = fmaxf(v0[j], 0.f), b = fmaxf(v1[j], 0.f); v0[j] = a * a; v1[j] = b * b; } }
                        *(u32x4*)(rowp + bj * 128) = pack8(v0, v1); } }
        } else if (mode == M_CONVIN) {
#pragma unroll
            for (int ai = 0; ai < 2; ++ai)
#pragma unroll
                for (int m = 0; m < 4; ++m) { const int row = r0 + ai * 128 + m * 16;
                    const float rs = __builtin_amdgcn_rsqf((float)sin[row] * (1.0f / (1024.0f * 1048576.0f)) + 1e-6f);
                    if (u.pn < 4) { bf16_t* rowp = o0 + (size_t)row * 1024 + u.pn * 256 + cw;
#pragma unroll
                        for (int bj = 0; bj < 2; ++bj) *(u32x4*)(rowp + bj * 128) = pack8(acc[ai][bj][m][0] * rs, acc[ai][bj][m][1] * rs);
                    } else { bf16_t* rowp = o1 + (size_t)row * 1024 + (u.pn - 4) * 128 + cw; const float r2 = rs * rs;
                        *(u32x4*)rowp = pack8(acc[ai][0][m][0] * acc[ai][1][m][0] * r2, acc[ai][0][m][1] * acc[ai][1][m][1] * r2); } }
        } else if (mode == M_RES) {
            f32x4 g[2][2];
#pragma unroll
            for (int bj = 0; bj < 2; ++bj)
#pragma unroll
                for (int n = 0; n < 2; ++n) g[bj][n] = f1 ? *(const f32x4*)(f1 + u.pn * 256 + bj * 128 + cw + 4 * n) : (f32x4){1.f, 1.f, 1.f, 1.f};
#pragma unroll
            for (int ai = 0; ai < 2; ++ai)
#pragma unroll
                for (int m = 0; m < 4; ++m) { const int row = r0 + ai * 128 + m * 16; const size_t off = (size_t)row * 1024 + u.pn * 256 + cw; float ssq = 0.f;
#pragma unroll
                    for (int bj = 0; bj < 2; ++bj) { const f32x4 x0 = *(const f32x4*)(f0 + off + bj * 128), x1 = *(const f32x4*)(f0 + off + bj * 128 + 4);
                        const f32x4 v0 = acc[ai][bj][m][0] + x0, v1 = acc[ai][bj][m][1] + x1;
                        *(f32x4*)(f2 + off + bj * 128) = v0; *(f32x4*)(f2 + off + bj * 128 + 4) = v1;
                        ssq += (v0[0] * v0[0] + v0[1] * v0[1]) + (v0[2] * v0[2] + v0[3] * v0[3]) + (v1[0] * v1[0] + v1[1] * v1[1]) + (v1[2] * v1[2] + v1[3] * v1[3]);
                        if (o0) *(u32x4*)(o0 + off + bj * 128) = pack8(v0 * g[bj][0], v1 * g[bj][1]); }
                    if (sout) { ssq += __shfl_xor(ssq, 16); ssq += __shfl_xor(ssq, 32); if (fq == 0) atomicAdd(sout + row, (unsigned long long)(ssq * 1048576.0f + 0.5f)); } }
        } else if (mode == M_GLU) {
            f32x4 g[2];
#pragma unroll
            for (int n = 0; n < 2; ++n) g[n] = *(const f32x4*)(f1 + u.pn * 128 + cw + 4 * n);
#pragma unroll
            for (int ai = 0; ai < 2; ++ai)
#pragma unroll
                for (int m = 0; m < 4; ++m) { const int row = r0 + ai * 128 + m * 16; const size_t off = (size_t)row * 1024 + u.pn * 128 + cw;
                    f32x4 v[2]; float ssq = 0.f;
#pragma unroll
                    for (int n = 0; n < 2; ++n) { const f32x4 x = *(const f32x4*)(f0 + off + 4 * n); const f32x4 val = acc[ai][0][m][n], gate = acc[ai][1][m][n];
#pragma unroll
                        for (int j = 0; j < 4; ++j) { const float sg = __builtin_amdgcn_rcpf(1.0f + __builtin_amdgcn_exp2f(-1.4426950409f * gate[j])); v[n][j] = x[j] + val[j] * sg; ssq += v[n][j] * v[n][j]; }
                        *(f32x4*)(f2 + off + 4 * n) = v[n]; }
                    *(u32x4*)(o0 + off) = pack8(v[0] * g[0], v[1] * g[1]);
                    ssq += __shfl_xor(ssq, 16); ssq += __shfl_xor(ssq, 32); if (fq == 0) atomicAdd(sout + row, (unsigned long long)(ssq * 1048576.0f + 0.5f)); }
        } else if (mode == M_P) {
#pragma unroll
            for (int ai = 0; ai < 2; ++ai)
#pragma unroll
                for (int m = 0; m < 4; ++m) { const int row = r0 + ai * 128 + m * 16; bf16_t* rowp = o0 + (size_t)row * 1024 + u.pn * 256 + cw; float s = 0.f;
#pragma unroll
                    for (int bj = 0; bj < 2; ++bj) { f32x4 v0, v1;
#pragma unroll
                        for (int j = 0; j < 4; ++j) { v0[j] = __builtin_amdgcn_exp2f(acc[ai][bj][m][0][j]); v1[j] = __builtin_amdgcn_exp2f(acc[ai][bj][m][1][j]); s += v0[j] + v1[j]; }
                        *(u32x4*)(rowp + bj * 128) = pack8(v0, v1); }
                    s += __shfl_xor(s, 16); s += __shfl_xor(s, 32); if (fq == 0) atomicAdd(sout + (size_t)row * 4 + u.pn, (unsigned long long)(s * 65536.0f + 0.5f)); }
        } else if (mode == M_O) {
#pragma unroll
            for (int ai = 0; ai < 2; ++ai)
#pragma unroll
                for (int m = 0; m < 4; ++m) { const int row = r0 + ai * 128 + m * 16; const float inv = 65536.0f / (float)sin[(size_t)row * 4 + u.pn];
                    bf16_t* rowp = o0 + (size_t)row * 1024 + u.pn * 256 + cw;
#pragma unroll
                    for (int bj = 0; bj < 2; ++bj) *(u32x4*)(rowp + bj * 128) = pack8(acc[ai][bj][m][0] * inv, acc[ai][bj][m][1] * inv); }
        } else if (mode == M_G) {
#pragma unroll
            for (int ai = 0; ai < 2; ++ai)
#pragma unroll
                for (int m = 0; m < 4; ++m) { float* p = f2 + (size_t)(r0 + ai * 128 + m * 16) * 128 + cw;
                    *(f32x4*)p = acc[ai][0][m][0]; *(f32x4*)(p + 4) = acc[ai][0][m][1]; }
        } else {
            const int b = u.pm >> 6, g = u.pm & 63, ho0 = (fq & 1) * 8;
            const f32x4 d0 = *(const f32x4*)(f1 + g * 16 + ho0), d1 = *(const f32x4*)(f1 + g * 16 + ho0 + 4);
#pragma unroll
            for (int ai = 0; ai < 2; ++ai)
#pragma unroll
                for (int m = 0; m < 4; ++m) { const int c = ai * 128 + wr * 64 + m * 16 + fr;
#pragma unroll
                    for (int bj = 0; bj < 2; ++bj) { const int jt = bj * 8 + wc * 2 + (fq >> 1);
                        const u32x4 uw = *(const u32x4*)(b0 + ((size_t)u.pm * 256 + c) * 384 + jt * 16 + ho0);
                        f32x4 v0 = acc[ai][bj][m][0], v1 = acc[ai][bj][m][1];
                        v0[0] += d0[0] * bf_lo(uw.x); v0[1] += d0[1] * bf_hi(uw.x); v0[2] += d0[2] * bf_lo(uw.y); v0[3] += d0[3] * bf_hi(uw.y);
                        v1[0] += d1[0] * bf_lo(uw.z); v1[1] += d1[1] * bf_hi(uw.z); v1[2] += d1[2] * bf_lo(uw.w); v1[3] += d1[3] * bf_hi(uw.w);
#pragma unroll
                        for (int j = 0; j < 4; ++j) { v0[j] = gelu_tanh(v0[j]); v1[j] = gelu_tanh(v1[j]); }
                        *(u32x4*)(o0 + ((size_t)b * 4096 + c * 16 + jt) * 1024 + g * 16 + ho0) = pack8(v0, v1); } }
        }
    }
};

template <class Epi, class Sched, bool ALIGN_EPI = false, bool SP2 = false>
__device__ __forceinline__ void gemm_phase(PG8_LAS unsigned char* lds, const int lda, const int ldb, const int K, const Sched& S, const Epi& E, const int tid) {
    const int wid = __builtin_amdgcn_readfirstlane(tid >> 6), lane = tid & 63, wr = wid >> 2, wc = wid & 3, fr = lane & 15, fq = lane >> 4;
    const int nt = K / BK;
    unsigned voffA[2], voffB[2];
#pragma unroll
    for (int i = 0; i < 2; ++i) { int R, C; stage_rc(tid * 16 + i * 8192, R, C); const int Rb = Epi::PERM ? ((R & ~31) + perm32(R & 31)) : R;
        voffA[i] = (unsigned)(R * lda + C) * 2u; voffB[i] = (unsigned)(Rb * ldb + C) * 2u; }
    const size_t kstep = (size_t)(BK * 2);
    const size_t hstepA = (size_t)HALF * lda * 2, hstepB = (size_t)HALF * ldb * 2;
    const unsigned ldsw = (unsigned)wid * 1024u;
    const int aoff = lds_byte(wr * 64 + fr, fq * 8), boff = lds_byte(wc * 32 + fr, fq * 8);
#define PG8_SA(b, h) (((b) * 2 + (h)) * HTB)
#define PG8_SB(b, h) ((4 + (b) * 2 + (h)) * HTB)
#define PG8_STAGE(bufoff, gbase, voff) do { _Pragma("unroll") for (int _i = 0; _i < 2; ++_i) \
        __builtin_amdgcn_global_load_lds((const unsigned*)((const char*)(gbase) + (voff)[_i]), (PG8_LAS unsigned*)(lds + (bufoff) + ldsw + _i * 8192), 16, 0, 0); } while (0)
#define PG8_LDA(dst, b, h) do { _Pragma("unroll") for (int m = 0; m < 4; ++m) _Pragma("unroll") for (int k = 0; k < 2; ++k) dst[m][k] = *(const PG8_LAS bf16x8*)(lds + PG8_SA(b, h) + aoff + m * 2048 + k * 1024); } while (0)
#define PG8_LDB(dst, b, h) do { _Pragma("unroll") for (int n = 0; n < 2; ++n) _Pragma("unroll") for (int k = 0; k < 2; ++k) dst[n][k] = *(const PG8_LAS bf16x8*)(lds + PG8_SB(b, h) + boff + n * 2048 + k * 1024); } while (0)
#define PG8_MMA(ai, bj, At, Bt) do { __builtin_amdgcn_s_setprio(1); _Pragma("unroll") for (int m = 0; m < 4; ++m) _Pragma("unroll") for (int n = 0; n < 2; ++n) _Pragma("unroll") for (int k = 0; k < 2; ++k) \
        acc[ai][bj][m][n] = __builtin_amdgcn_mfma_f32_16x16x32_bf16(Bt[n][k], At[m][k], acc[ai][bj][m][n], 0, 0, 0); __builtin_amdgcn_s_setprio(0); } while (0)
#define PG8_WAIT_V(n) asm volatile("s_waitcnt vmcnt(" #n ")" ::: "memory")
#define PG8_WAIT_L(n) asm volatile("s_waitcnt lgkmcnt(" #n ")" ::: "memory")
#define PG8_BAR __builtin_amdgcn_s_barrier()
#define PG8_SCHED __builtin_amdgcn_sched_barrier(0)
    Unit cur, nxt; int ui = 0;
    if (!S.next(0, cur)) return;
    f32x4 acc[2][2][4][2];
#pragma unroll
    for (int a = 0; a < 2; ++a)
#pragma unroll
        for (int b = 0; b < 2; ++b)
#pragma unroll
            for (int m = 0; m < 4; ++m)
#pragma unroll
                for (int n = 0; n < 2; ++n) acc[a][b][m][n] = (f32x4){0.f, 0.f, 0.f, 0.f};
    bf16x8 At[4][2], B0[2][2], B1[2][2];
    const char* cA = S.abase(cur); const char* cB = S.bbase(cur);
    if constexpr (SP2) {
        PG8_STAGE(PG8_SB(0, 0), cB, voffB); PG8_STAGE(PG8_SB(0, 1), cB + hstepB, voffB); PG8_STAGE(PG8_SA(0, 0), cA, voffA); PG8_STAGE(PG8_SA(0, 1), cA + hstepA, voffA);
        if (wr == 1) PG8_BAR;
        PG8_WAIT_V(2); PG8_BAR;
        PG8_STAGE(PG8_SB(1, 0), cB + kstep, voffB); PG8_STAGE(PG8_SA(1, 0), cA + kstep, voffA); PG8_STAGE(PG8_SB(1, 1), cB + hstepB + kstep, voffB);
        PG8_WAIT_V(6); PG8_BAR;
    } else {
        PG8_STAGE(PG8_SB(0, 0), cB, voffB); PG8_STAGE(PG8_SA(0, 0), cA, voffA); PG8_STAGE(PG8_SB(0, 1), cB + hstepB, voffB); PG8_STAGE(PG8_SA(0, 1), cA + hstepA, voffA);
        if (wr == 1) PG8_BAR;
        PG8_WAIT_V(4); PG8_BAR;
        PG8_STAGE(PG8_SB(1, 0), cB + kstep, voffB); PG8_STAGE(PG8_SA(1, 0), cA + kstep, voffA); PG8_STAGE(PG8_SB(1, 1), cB + hstepB + kstep, voffB);
        PG8_WAIT_V(6); PG8_BAR;
    }
    for (;;) {
        const bool has_next = S.next(ui + 1, nxt);
        const char* nA = has_next ? S.abase(nxt) : cA; const char* nB = has_next ? S.bbase(nxt) : cB;
        for (int t = 0; t < nt; t += 2) {
            const bool last = (t == nt - 2);
            const char* a1 = cA + (size_t)(t + 1) * kstep;
            const char* a2 = last ? nA : cA + (size_t)(t + 2) * kstep; const char* b2 = last ? nB : cB + (size_t)(t + 2) * kstep;
            const char* a3 = a2 + kstep; const char* b3 = b2 + kstep;
            if constexpr (SP2) {
            PG8_LDB(B0, 0, 0); PG8_LDB(B1, 0, 1); PG8_SCHED; PG8_LDA(At, 0, 0); PG8_STAGE(PG8_SA(1, 1), a1 + hstepA, voffA);
            PG8_WAIT_V(8); PG8_WAIT_L(0); PG8_BAR; PG8_MMA(0, 0, At, B0); PG8_MMA(0, 1, At, B1); PG8_BAR; PG8_SCHED;
            PG8_LDA(At, 0, 1); PG8_STAGE(PG8_SB(0, 0), b2, voffB); PG8_STAGE(PG8_SB(0, 1), b2 + hstepB, voffB); PG8_STAGE(PG8_SA(0, 0), a2, voffA);
            PG8_WAIT_V(8); PG8_WAIT_L(0); PG8_BAR; PG8_MMA(1, 0, At, B0); PG8_MMA(1, 1, At, B1); PG8_BAR; PG8_SCHED;
            PG8_LDB(B0, 1, 0); PG8_LDB(B1, 1, 1); PG8_SCHED; PG8_LDA(At, 1, 0); PG8_STAGE(PG8_SA(0, 1), a2 + hstepA, voffA);
            PG8_WAIT_V(8); PG8_WAIT_L(0); PG8_BAR; PG8_MMA(0, 0, At, B0); PG8_MMA(0, 1, At, B1); PG8_BAR; PG8_SCHED;
            PG8_LDA(At, 1, 1); PG8_STAGE(PG8_SB(1, 0), b3, voffB); PG8_STAGE(PG8_SB(1, 1), b3 + hstepB, voffB); PG8_STAGE(PG8_SA(1, 0), a3, voffA);
            PG8_WAIT_V(8); PG8_WAIT_L(0); PG8_BAR; PG8_MMA(1, 0, At, B0); PG8_MMA(1, 1, At, B1); PG8_BAR; PG8_SCHED;
            } else {
            PG8_LDB(B0, 0, 0); PG8_SCHED; PG8_LDA(At, 0, 0); PG8_STAGE(PG8_SA(1, 1), a1 + hstepA, voffA);
            PG8_WAIT_L(8); PG8_BAR; PG8_WAIT_L(0); PG8_MMA(0, 0, At, B0); PG8_BAR; PG8_SCHED;
            PG8_LDB(B1, 0, 1); PG8_STAGE(PG8_SB(0, 0), b2, voffB);
            PG8_BAR; PG8_WAIT_L(0); PG8_MMA(0, 1, At, B1); PG8_BAR;
            PG8_LDA(At, 0, 1); PG8_STAGE(PG8_SA(0, 0), a2, voffA);
            PG8_BAR; PG8_WAIT_L(0); PG8_MMA(1, 0, At, B0); PG8_BAR; PG8_SCHED;
            PG8_STAGE(PG8_SB(0, 1), b2 + hstepB, voffB);
            PG8_WAIT_V(6); PG8_BAR; PG8_MMA(1, 1, At, B1); PG8_BAR;
            PG8_LDB(B0, 1, 0); PG8_SCHED; PG8_LDA(At, 1, 0); PG8_STAGE(PG8_SA(0, 1), a2 + hstepA, voffA);
            PG8_WAIT_L(8); PG8_BAR; PG8_WAIT_L(0); PG8_MMA(0, 0, At, B0); PG8_BAR; PG8_SCHED;
            PG8_LDB(B1, 1, 1); PG8_STAGE(PG8_SB(1, 0), b3, voffB);
            PG8_BAR; PG8_WAIT_L(0); PG8_MMA(0, 1, At, B1); PG8_BAR;
            PG8_LDA(At, 1, 1); PG8_STAGE(PG8_SA(1, 0), a3, voffA);
            PG8_BAR; PG8_WAIT_L(0); PG8_MMA(1, 0, At, B0); PG8_BAR; PG8_SCHED;
            PG8_STAGE(PG8_SB(1, 1), b3 + hstepB, voffB);
            PG8_WAIT_V(6); PG8_BAR; PG8_MMA(1, 1, At, B1); PG8_BAR;
            }
        }
        if constexpr (ALIGN_EPI) { if (wr == 0) PG8_BAR; }
        { int frv = fr, fqv = fq; asm volatile("" : "+v"(frv), "+v"(fqv)); E(acc, cur, wr, wc, frv, fqv); }
        if (!has_next) break;
#pragma unroll
        for (int a = 0; a < 2; ++a)
#pragma unroll
            for (int b = 0; b < 2; ++b)
#pragma unroll
                for (int m = 0; m < 4; ++m)
#pragma unroll
                    for (int n = 0; n < 2; ++n) acc[a][b][m][n] = (f32x4){0.f, 0.f, 0.f, 0.f};
        cur = nxt; cA = nA; cB = nB; ++ui;
        if constexpr (ALIGN_EPI) { if (wr == 1) PG8_BAR; }
    }
    PG8_WAIT_V(0);
    if constexpr (!ALIGN_EPI) { if (wr == 0) PG8_BAR; }
    PG8_BAR;
#undef PG8_SA
#undef PG8_SB
#undef PG8_STAGE
#undef PG8_LDA
#undef PG8_LDB
#undef PG8_MMA
#undef PG8_WAIT_V
#undef PG8_WAIT_L
#undef PG8_BAR
#undef PG8_SCHED
}
}
using pg8::bf16_t; using pg8::f32x4; using pg8::u32x4; using pg8::u32x2;
#define LAS __attribute__((address_space(3)))

constexpr int BATCH = 8, SEQ = 4096, D = 1024, T = BATCH * SEQ, DEPTH = 4, NMEM = 256, HEADS = 4, HD = 256, FF = 4096;
constexpr int SG = 64, SP = 64, SH = 16, CL = 16, NCH = SEQ / CL;
constexpr int KX = CL * SH + 2 * SP;
constexpr float EPS = 1e-6f;
constexpr int NWAVES = 8, NTHR = 512;
constexpr int LDS_BYTES = 147456;

constexpr size_t MiB = 1u << 20;
constexpr size_t WS_SS = 0;
constexpr size_t WS_L = 4 * MiB;
constexpr size_t WS_ZERO_BYTES = 8 * MiB;
constexpr size_t WS_TAB = 8 * MiB;
constexpr size_t WS_F = 9 * MiB;
constexpr size_t WS_W2X = 14 * MiB;
constexpr size_t WS_MEMN = 26 * MiB;
constexpr size_t WS_KB = 30 * MiB;
constexpr size_t WS_VT = 46 * MiB;
constexpr size_t WS_WGLU = 62 * MiB, WS_WIN = 70 * MiB, WS_WOUT = 82 * MiB, WS_WQ = 86 * MiB, WS_WK = 94 * MiB, WS_WV = 102 * MiB, WS_WO = 110 * MiB, WS_W1 = 118 * MiB, WS_W2 = 150 * MiB;
constexpr size_t WS_XG = 182 * MiB;
constexpr size_t WS_BIG = 246 * MiB;
constexpr size_t WS_END = 502 * MiB;
constexpr size_t BG_H = 0, BG_Q = 0, BG_P = 64 * MiB, BG_BC = 0, BG_Z = 64 * MiB, BG_UC = 128 * MiB, BG_UEXT = 0, BG_G = 96 * MiB, BG_Y = 160 * MiB;

struct Args { const float* in[24]; float* out; unsigned char* ws; };

__device__ __forceinline__ float wave_sum(float v) {
#pragma unroll
    for (int o = 1; o < 64; o <<= 1) v += __shfl_xor(v, o);
    return v;
}
__device__ __forceinline__ unsigned f2bf(float f) { unsigned u = __float_as_uint(f); return (u + 0x7fffu + ((u >> 16) & 1u)) >> 16; }
__device__ __forceinline__ unsigned pk2(float lo, float hi) { return f2bf(lo) | (f2bf(hi) << 16); }

__device__ __forceinline__ void transpose_item(const float* W, int K, int N, bf16_t* drow0, int k0, int n0, LAS float* scr, int lane) {
#pragma unroll 8
    for (int i = 0; i < 32; ++i) { const int kk = 2 * i + (lane >> 5); scr[kk * 33 + (lane & 31)] = W[(size_t)(k0 + kk) * N + n0 + (lane & 31)]; }
    asm volatile("s_waitcnt lgkmcnt(0)" ::: "memory");
    const int c = lane & 7;
#pragma unroll
    for (int j = 0; j < 4; ++j) { const int n = (lane >> 3) + 8 * j; const LAS float* s = scr + (8 * c) * 33 + n;
        u32x4 o; o.x = pk2(s[0 * 33], s[1 * 33]); o.y = pk2(s[2 * 33], s[3 * 33]); o.z = pk2(s[4 * 33], s[5 * 33]); o.w = pk2(s[6 * 33], s[7 * 33]);
        *(u32x4*)(drow0 + (size_t)n * K + k0 + 8 * c) = o; }
    asm volatile("s_waitcnt lgkmcnt(0)" ::: "memory");
}

__device__ __forceinline__ void rms_row(const float* xrow, const float* gain, int lane, f32x4 (&v)[4]) {
    const f32x4* xr = (const f32x4*)xrow + lane; const f32x4* gr = (const f32x4*)gain + lane; float s = 0.f;
#pragma unroll
    for (int j = 0; j < 4; ++j) { v[j] = xr[64 * j]; s += (v[j][0] * v[j][0] + v[j][1] * v[j][1]) + (v[j][2] * v[j][2] + v[j][3] * v[j][3]); }
    const float rstd = 1.0f / sqrtf(wave_sum(s) * (1.0f / D) + EPS);
#pragma unroll
    for (int j = 0; j < 4; ++j) v[j] = v[j] * rstd * gr[64 * j];
}

__device__ __forceinline__ void norm_chunk_to_uext(const float* x, const float* gain, bf16_t* uext, int ci, LAS unsigned char* lds, int wave, int lane) {
    const int b = ci >> 8, c = ci & 255; const size_t t0 = (size_t)b * SEQ + c * CL;
    constexpr int PITCH = 2064;
#pragma unroll
    for (int r = 0; r < 2; ++r) { const int tok = r * 8 + wave; f32x4 v[4]; rms_row(x + (t0 + tok) * D, gain, lane, v);
#pragma unroll
        for (int j = 0; j < 4; ++j) { u32x2 w; w.x = pk2(v[j][0], v[j][1]); w.y = pk2(v[j][2], v[j][3]); *(LAS u32x2*)(lds + tok * PITCH + (4 * lane + 256 * j) * 2) = w; } }
    __syncthreads();
    const int l32 = lane & 31, tk = l32 >> 1, half = l32 & 1;
#pragma unroll
    for (int gi = 0; gi < 8; gi += 2) { const int g = wave * 8 + gi + (lane >> 5);
        const u32x4 w = *(const LAS u32x4*)(lds + tk * PITCH + (g * 16 + half * 8) * 2);
        *(u32x4*)(uext + ((size_t)(b * 64 + g) * 256 + c) * KX + tk * 16 + half * 8) = w; }
    __syncthreads();
}

__device__ __forceinline__ void build_ssm(const Args& a, int j, int g, LAS unsigned char* lds, int tid) {
    typedef float f32x2 __attribute__((ext_vector_type(2)));
    LAS f32x2* pw = (LAS f32x2*)lds;
    LAS f32x2* bb = (LAS f32x2*)(lds + 8704);
    LAS f32x2* cc = (LAS f32x2*)(lds + 16896);
    LAS float* kk = (LAS float*)(lds + 25088);
    const float* a_re = a.in[6] + (size_t)(j * SG + g) * SP; const float* a_im = a.in[7] + (size_t)(j * SG + g) * SP;
    const float dt = expf(a.in[8][j * SG + g]);
    const float* b_re = a.in[9] + (size_t)(j * SG + g) * SP * SH; const float* b_im = a.in[10] + (size_t)(j * SG + g) * SP * SH;
    const float* c_re = a.in[11] + (size_t)(j * SG + g) * SH * SP; const float* c_im = a.in[12] + (size_t)(j * SG + g) * SH * SP;
    if (tid < 64) { const float are = a_re[tid], aim = a_im[tid];
        for (int k = 0; k <= 16; ++k) { const float mag = expf(are * dt * (float)k); double ang = (double)aim * (double)dt * (double)k; ang -= 6.283185307179586 * rint(ang * 0.15915494309189535);
            float sn, cs; sincosf((float)ang, &sn, &cs); pw[k * 64 + tid] = (f32x2){mag * cs, mag * sn}; }
        const float mag = expf(are * dt * 1024.0f); double ang = (double)aim * (double)dt * 1024.0; ang -= 6.283185307179586 * rint(ang * 0.15915494309189535);
        float sn, cs; sincosf((float)ang, &sn, &cs);
        f32x4 t; t[0] = pw[16 * 64 + tid].x; t[1] = pw[16 * 64 + tid].y; t[2] = mag * cs; t[3] = mag * sn;
        *(f32x4*)(a.ws + WS_TAB + ((size_t)g * 64 + tid) * 16) = t; }
    __syncthreads();
    for (int idx = tid; idx < 1024; idx += NTHR) { const int p = idx >> 4;
        const float are = a_re[p], aim = a_im[p]; const f32x2 ab = pw[64 + p];
        const float nr = ab.x - 1.0f, ni = ab.y, den = 1.0f / (are * are + aim * aim);
        const float qr = (nr * are + ni * aim) * den, qi = (ni * are - nr * aim) * den;
        const float br = b_re[idx], bi = b_im[idx];
        bb[idx] = (f32x2){qr * br - qi * bi, qr * bi + qi * br};
        cc[idx] = (f32x2){c_re[idx], c_im[idx]}; }
    __syncthreads();
    for (int idx = tid; idx < 4096; idx += NTHR) { const int k = idx >> 8, ho = (idx >> 4) & 15, hi = idx & 15; float s = 0.f;
        for (int p = 0; p < 64; ++p) { const f32x2 c = cc[ho * 64 + p], w = pw[k * 64 + p], bq = bb[p * 16 + hi];
            const float tr = c.x * w.x - c.y * w.y, ti = c.x * w.y + c.y * w.x; s += tr * bq.x - ti * bq.y; }
        kk[idx] = s; }
    __syncthreads();
    unsigned* w2 = (unsigned*)(a.ws + WS_W2X) + (size_t)g * 256 * (KX / 2);
    for (int idx = tid; idx < 256 * (KX / 2); idx += NTHR) { const int n = idx / (KX / 2), kc = (idx % (KX / 2)) * 2, jt = n >> 4, ho = n & 15; float v0, v1;
        if (kc < 256) { const int i = kc >> 4, hi = kc & 15; if (i <= jt) { v0 = kk[((jt - i) * 16 + ho) * 16 + hi]; v1 = kk[((jt - i) * 16 + ho) * 16 + hi + 1]; } else { v0 = 0.f; v1 = 0.f; } }
        else { const int p = (kc - 256) & 63; const f32x2 c0 = cc[ho * 64 + p], c1 = cc[ho * 64 + p + 1], w0 = pw[(jt + 1) * 64 + p], w1 = pw[(jt + 1) * 64 + p + 1];
            if (kc < 320) { v0 = c0.x * w0.x - c0.y * w0.y; v1 = c1.x * w1.x - c1.y * w1.y; } else { v0 = -(c0.x * w0.y + c0.y * w0.x); v1 = -(c1.x * w1.y + c1.y * w1.x); } }
        w2[idx] = pk2(v0, v1); }
    unsigned* fm = (unsigned*)(a.ws + WS_F) + (size_t)g * 128 * 128;
    for (int idx = tid; idx < 128 * 128; idx += NTHR) { const int n = idx >> 7, kc = (idx & 127) * 2, p = n & 63, i = kc >> 4, hi = kc & 15;
        const f32x2 w = pw[(15 - i) * 64 + p], q0 = bb[p * 16 + hi], q1 = bb[p * 16 + hi + 1]; float v0, v1;
        if (n < 64) { v0 = w.x * q0.x - w.y * q0.y; v1 = w.x * q1.x - w.y * q1.y; } else { v0 = w.x * q0.y + w.y * q0.x; v1 = w.x * q1.y + w.y * q1.x; }
        fm[idx] = pk2(v0, v1); }
    __syncthreads();
}

__device__ __forceinline__ void ssm_scan(const Args& a, LAS unsigned char* lds, int G, int wave, int lane) {
    typedef float f32x2 __attribute__((ext_vector_type(2)));
    LAS f32x2* ex = (LAS f32x2*)lds;
    const float* Gb = (const float*)(a.ws + WS_BIG + BG_G); bf16_t* ue = (bf16_t*)(a.ws + WS_BIG + BG_UEXT);
    for (int pair = blockIdx.x; pair < 256; pair += G) {
        const int bg = pair * 2 + (wave >> 2), seg = wave & 3, g = bg & 63, p = lane;
        const f32x4 tb = *(const f32x4*)(a.ws + WS_TAB + ((size_t)g * 64 + p) * 16);
        const float* gp = Gb + ((size_t)bg * 256 + seg * 64) * 128 + p;
        float er = 0.f, ei = 0.f;
        for (int c0 = 0; c0 < 64; c0 += 16) { float gr[16], gi[16];
#pragma unroll
            for (int k = 0; k < 16; ++k) { gr[k] = gp[(size_t)(c0 + k) * 128]; gi[k] = gp[(size_t)(c0 + k) * 128 + 64]; }
#pragma unroll
            for (int k = 0; k < 16; ++k) { const float nr = tb[0] * er - tb[1] * ei + gr[k], ni = tb[0] * ei + tb[1] * er + gi[k]; er = nr; ei = ni; } }
        ex[wave * 64 + p] = (f32x2){er, ei};
        __syncthreads();
        float sr = 0.f, si = 0.f;
        for (int s = 0; s < seg; ++s) { const f32x2 e = ex[((wave & 4) + s) * 64 + p]; const float nr = tb[2] * sr - tb[3] * si + e.x, ni = tb[2] * si + tb[3] * sr + e.y; sr = nr; si = ni; }
        bf16_t* up = ue + ((size_t)bg * 256 + seg * 64) * KX + 256 + p;
        for (int c0 = 0; c0 < 64; c0 += 16) { float gr[16], gi[16];
#pragma unroll
            for (int k = 0; k < 16; ++k) { gr[k] = gp[(size_t)(c0 + k) * 128]; gi[k] = gp[(size_t)(c0 + k) * 128 + 64]; }
#pragma unroll
            for (int k = 0; k < 16; ++k) { up[(size_t)(c0 + k) * KX] = (bf16_t)f2bf(sr); up[(size_t)(c0 + k) * KX + 64] = (bf16_t)f2bf(si);
                const float nr = tb[0] * sr - tb[1] * si + gr[k], ni = tb[0] * si + tb[1] * sr + gi[k]; sr = nr; si = ni; } }
        __syncthreads();
    }
}

enum { PH_P0 = 0, PH_KVK, PH_KVV, PH_SSM1, PH_SCAN, PH_SSM3, PH_GLU, PH_Q, PH_SP, PH_OV, PH_WO, PH_UP, PH_DOWN, PH_CONVIN, PH_CONV, PH_CONVOUT, PH_NORM2, PH_FINAL };
constexpr int NPROG = 43;

__global__ void __launch_bounds__(NTHR, 2) mega_fwd(Args a) {
    extern __shared__ __attribute__((aligned(16))) unsigned char lds_raw[];
    cg::grid_group grid = cg::this_grid();
    LAS unsigned char* lds = (LAS unsigned char*)lds_raw;
    const int Gn = gridDim.x, bx = blockIdx.x;
    const int vcu = (Gn % 8 == 0) ? (bx % 8) * (Gn / 8) + bx / 8 : bx;
    const int NGW = Gn * NWAVES;
    unsigned char* ws = a.ws;
    float* const xres = a.out;
    bf16_t* const XG = (bf16_t*)(ws + WS_XG);
    unsigned char* const big = ws + WS_BIG;

#pragma nounroll
    for (int pi = 0; pi < NPROG; ++pi) {
        int ph, l = 0;
        if (pi < 3) ph = pi;
        else { int q = pi - 3;
            if (q == 19) ph = PH_NORM2; else if (q == 39) ph = PH_FINAL;
            else { if (q >= 20) { q -= 20; l = 2; } int r = q; if (q >= 10) { r = q - 10; l += 1; }
                if (l & 1) ph = (r < 3) ? PH_CONVIN + r : PH_Q + (r - 3); else ph = (r < 4) ? PH_SSM1 + r : PH_Q + (r - 4); } }
        const int j = l >> 1;
        int tidv = threadIdx.x; asm volatile("" : "+v"(tidv));
        const int tid = tidv, lane = tid & 63, wave = __builtin_amdgcn_readfirstlane(tid >> 6), gw = vcu * NWAVES + wave;
        bool is_gemm = true, do_sync = true;
        pg8::Order S; pg8::Epi E; int lda = D, ldb = D, K = D;
        S.G = Gn; S.c = bx; S.an = 0; S.bb = 0; S.bg = 0; S.nM = T / 256; S.nN = 4; S.A = nullptr; S.B = nullptr; S.am = 256L * D * 2; S.bn = 256L * D * 2;
        E.mode = pg8::M_STORE; E.ldc = D; E.mul = 1.0f; E.o0 = nullptr; E.o1 = nullptr; E.f0 = nullptr; E.f1 = nullptr; E.f2 = nullptr; E.b0 = nullptr; E.sin = nullptr; E.sout = nullptr;
        unsigned long long* const SSb = (unsigned long long*)(ws + WS_SS); unsigned long long* const Lb = (unsigned long long*)(ws + WS_L) + (size_t)l * T * 4;
        switch (ph) {
        case PH_P0: { is_gemm = false;
            { f32x4* z = (f32x4*)ws; const f32x4 zero = {0.f, 0.f, 0.f, 0.f}; for (int i = bx * NTHR + tid; i < (int)(WS_ZERO_BYTES / 16); i += Gn * NTHR) z[i] = zero; }
            LAS float* scr = (LAS float*)(lds + wave * 8448);
            for (int it = gw; it < 30720; it += NGW) {
                int r = it, idx, K_ = 1024, N_ = 1024, typ; const float* src;
                if (r < 2048) { idx = r >> 10; r &= 1023; src = a.in[14] + (size_t)idx * 1024 * 2048; N_ = 2048; typ = 0; }
                else if ((r -= 2048) < 3072) { idx = r / 1536; r %= 1536; src = a.in[15] + (size_t)idx * 1024 * 3072; N_ = 3072; typ = 1; }
                else if ((r -= 3072) < 1024) { idx = r >> 9; r &= 511; src = a.in[17] + (size_t)idx * 1024 * 1024; typ = 2; }
                else if ((r -= 1024) < 2048) { idx = r >> 9; r &= 511; src = a.in[18] + (size_t)idx * 1024 * 1024; typ = 3; }
                else if ((r -= 2048) < 4096) { idx = r >> 10; r &= 1023; src = a.in[19] + (size_t)idx * 1024 * 2048; N_ = 2048; typ = 4; }
                else if ((r -= 4096) < 2048) { idx = r >> 9; r &= 511; src = a.in[20] + (size_t)idx * 1024 * 1024; typ = 5; }
                else if ((r -= 2048) < 8192) { idx = r >> 11; r &= 2047; src = a.in[21] + (size_t)idx * 1024 * 4096; N_ = 4096; typ = 6; }
                else { r -= 8192; idx = r >> 11; r &= 2047; src = a.in[22] + (size_t)idx * 4096 * 1024; K_ = 4096; typ = 7; }
                const int nblk = N_ / 32, kb = r / nblk, nb = r % nblk, k0 = 64 * kb, n0 = 32 * nb; bf16_t* dst;
                switch (typ) {
                case 0: { const int n1 = n0 & 1023, row = (n1 >> 7) * 256 + (n0 >= 1024 ? 128 : 0) + (n1 & 127); dst = (bf16_t*)(ws + WS_WGLU) + ((size_t)idx * 2048 + row) * 1024; } break;
                case 1: { int row; if (n0 < 1024) row = n0; else { const int n1 = (n0 - 1024) & 1023; row = 1024 + (n1 >> 7) * 256 + (n0 >= 2048 ? 128 : 0) + (n1 & 127); } dst = (bf16_t*)(ws + WS_WIN) + ((size_t)idx * 3072 + row) * 1024; } break;
                case 2: dst = (bf16_t*)(ws + WS_WOUT) + ((size_t)idx * 1024 + n0) * 1024; break;
                case 3: dst = (bf16_t*)(ws + WS_WQ) + ((size_t)idx * 1024 + n0) * 1024; break;
                case 4: dst = (n0 < 1024) ? (bf16_t*)(ws + WS_WK) + ((size_t)idx * 1024 + n0) * 1024 : (bf16_t*)(ws + WS_WV) + ((size_t)idx * 1024 + n0 - 1024) * 1024; break;
                case 5: dst = (bf16_t*)(ws + WS_WO) + ((size_t)idx * 1024 + n0) * 1024; break;
                case 6: dst = (bf16_t*)(ws + WS_W1) + ((size_t)idx * 4096 + n0) * 1024; break;
                default: dst = (bf16_t*)(ws + WS_W2) + ((size_t)idx * 1024 + n0) * 4096; break;
                }
                transpose_item(src, K_, N_, dst, k0, n0, scr, lane);
            }
            for (int m = gw; m < BATCH * NMEM; m += NGW) { f32x4 v[4]; rms_row(a.in[1] + (size_t)m * D, a.in[2], lane, v); u32x2* o = (u32x2*)((bf16_t*)(ws + WS_MEMN) + (size_t)m * D) + lane;
#pragma unroll
                for (int jj = 0; jj < 4; ++jj) { u32x2 w; w.x = pk2(v[jj][0], v[jj][1]); w.y = pk2(v[jj][2], v[jj][3]); o[64 * jj] = w; } }
            __syncthreads();
            for (int ci = bx; ci < BATCH * NCH; ci += Gn) norm_chunk_to_uext(a.in[0], a.in[3], (bf16_t*)(big + BG_UEXT), ci, lds, wave, lane);
            for (int g = bx; g < SG; g += Gn) build_ssm(a, 0, g, lds, tid);
        } break;
        case PH_KVK: S.nM = BATCH * NMEM / 256; S.nN = 16; S.A = (const char*)(ws + WS_MEMN); S.B = (const char*)(ws + WS_WK); E.o0 = (bf16_t*)(ws + WS_KB); E.ldc = 4096; do_sync = false; break;
        case PH_KVV: S.nM = 16; S.nN = BATCH * NMEM / 256; S.A = (const char*)(ws + WS_WV); S.B = (const char*)(ws + WS_MEMN); E.o0 = (bf16_t*)(ws + WS_VT); E.ldc = 2048; S.c = (bx + Gn / 2) % Gn; do_sync = false; break;
        case PH_SSM1: S.nM = BATCH * SG; S.nN = 1; S.A = (const char*)(big + BG_UEXT); S.am = 256L * KX * 2; S.B = (const char*)(ws + WS_F); S.bn = 0; S.bg = 128L * 256 * 2; lda = KX; ldb = 256; K = 256;
            E.mode = pg8::M_G; E.f2 = (float*)(big + BG_G); break;
        case PH_SCAN: is_gemm = false; ssm_scan(a, lds, Gn, wave, lane); break;
        case PH_SSM3: S.nM = BATCH * SG; S.nN = 1; S.A = (const char*)(big + BG_UEXT); S.am = 256L * KX * 2; S.B = (const char*)(ws + WS_W2X); S.bn = 0; S.bg = 256L * KX * 2; lda = KX; ldb = KX; K = KX;
            E.mode = pg8::M_Y; E.o0 = (bf16_t*)(big + BG_Y); E.b0 = (const bf16_t*)(big + BG_UEXT); E.f1 = a.in[13] + (size_t)j * D; break;
        case PH_GLU: S.nN = 8; S.A = (const char*)(big + BG_Y); S.B = (const char*)(ws + WS_WGLU + (size_t)j * 2048 * 1024 * 2);
            E.mode = pg8::M_GLU; E.f0 = (l == 0) ? a.in[0] : xres; E.f2 = xres; E.o0 = XG; E.f1 = a.in[4] + (size_t)l * D; E.sout = SSb + (size_t)(l * 3 + 1) * T; break;
        case PH_Q: S.A = (const char*)XG; S.B = (const char*)(ws + WS_WQ + (size_t)l * 1024 * 1024 * 2);
            E.mode = pg8::M_SCALE; E.o0 = (bf16_t*)(big + BG_Q); E.sin = SSb + (size_t)(l * 3 + 1) * T; E.mul = 0.0625f * 1.4426950409f; break;
        case PH_SP: S.A = (const char*)(big + BG_Q); S.an = 256 * 2; S.B = (const char*)(ws + WS_KB + (size_t)l * 1024 * 2); S.bn = 256 * 2; S.bb = 256L * 4096 * 2; ldb = 4096; K = 256;
            E.mode = pg8::M_P; E.o0 = (bf16_t*)(big + BG_P); E.sout = Lb; break;
        case PH_OV: S.A = (const char*)(big + BG_P); S.an = 256 * 2; S.B = (const char*)(ws + WS_VT + (size_t)l * 1024 * 2048 * 2); S.bn = 256L * 2048 * 2; S.bb = 256 * 2; ldb = 2048; K = 256;
            E.mode = pg8::M_O; E.o0 = (bf16_t*)(big + BG_Q); E.sin = Lb; break;
        case PH_WO: S.A = (const char*)(big + BG_Q); S.B = (const char*)(ws + WS_WO + (size_t)l * 1024 * 1024 * 2);
            E.mode = pg8::M_RES; E.f0 = xres; E.f2 = xres; E.o0 = XG; E.f1 = a.in[5] + (size_t)l * D; E.sout = SSb + (size_t)(l * 3 + 2) * T; break;
        case PH_UP: S.nN = 16; S.A = (const char*)XG; S.B = (const char*)(ws + WS_W1 + (size_t)l * 4096 * 1024 * 2);
            E.mode = pg8::M_UP; E.o0 = (bf16_t*)(big + BG_H); E.ldc = FF; E.sin = SSb + (size_t)(l * 3 + 2) * T; break;
        case PH_DOWN: S.A = (const char*)(big + BG_H); S.am = 256L * FF * 2; S.B = (const char*)(ws + WS_W2 + (size_t)l * 4096 * 1024 * 2); S.bn = 256L * FF * 2; lda = FF; ldb = FF; K = FF;
            E.mode = pg8::M_RES; E.f0 = xres; E.f2 = xres;
            if ((l & 1) == 0) { E.o0 = XG; E.f1 = a.in[3] + (size_t)(l + 1) * D; E.sout = SSb + (size_t)((l + 1) * 3) * T; } break;
        case PH_CONVIN: S.nN = 12; S.A = (const char*)XG; S.B = (const char*)(ws + WS_WIN + (size_t)j * 3072 * 1024 * 2);
            E.mode = pg8::M_CONVIN; E.o0 = (bf16_t*)(big + BG_BC); E.o1 = (bf16_t*)(big + BG_Z); E.sin = SSb + (size_t)(l * 3) * T; break;
        case PH_CONV: { is_gemm = false;
            const bf16_t* Bc = (const bf16_t*)(big + BG_BC); const bf16_t* Z = (const bf16_t*)(big + BG_Z); bf16_t* Uc = (bf16_t*)(big + BG_UC); const float* cw = a.in[16] + (size_t)j * 3 * D;
            for (int i = bx * NTHR + tid; i < T * 128; i += Gn * NTHR) { const int t = i >> 7, c8 = (i & 127) * 8, tl = t & (SEQ - 1); const size_t off = (size_t)t * D + c8;
                const u32x4 z0 = *(const u32x4*)(Z + off), bv = *(const u32x4*)(Bc + off); u32x4 z1 = {0u, 0u, 0u, 0u}, z2 = {0u, 0u, 0u, 0u};
                if (tl >= 1) z1 = *(const u32x4*)(Z + off - D); if (tl >= 2) z2 = *(const u32x4*)(Z + off - 2 * D);
                f32x4 o0, o1;
#pragma unroll
                for (int q = 0; q < 4; ++q) { const int cc = c8 + 2 * q;
                    const float w0a = cw[cc], w0b = cw[cc + 1], w1a = cw[D + cc], w1b = cw[D + cc + 1], w2a = cw[2 * D + cc], w2b = cw[2 * D + cc + 1];
                    const float ra = pg8::bf_lo(bv[q]) * (w0a * pg8::bf_lo(z2[q]) + w1a * pg8::bf_lo(z1[q]) + w2a * pg8::bf_lo(z0[q]));
                    const float rb = pg8::bf_hi(bv[q]) * (w0b * pg8::bf_hi(z2[q]) + w1b * pg8::bf_hi(z1[q]) + w2b * pg8::bf_hi(z0[q]));
                    if (q < 2) { o0[2 * q] = ra; o0[2 * q + 1] = rb; } else { o1[2 * (q - 2)] = ra; o1[2 * (q - 2) + 1] = rb; } }
                *(u32x4*)(Uc + off) = pg8::pack8(o0, o1); }
        } break;
        case PH_CONVOUT: S.A = (const char*)(big + BG_UC); S.B = (const char*)(ws + WS_WOUT + (size_t)j * 1024 * 1024 * 2);
            E.mode = pg8::M_RES; E.f0 = xres; E.f2 = xres; E.o0 = XG; E.f1 = a.in[4] + (size_t)l * D; E.sout = SSb + (size_t)(l * 3 + 1) * T; break;
        case PH_NORM2: is_gemm = false;
            for (int ci = bx; ci < BATCH * NCH; ci += Gn) norm_chunk_to_uext(xres, a.in[3] + 2 * D, (bf16_t*)(big + BG_UEXT), ci, lds, wave, lane);
            for (int g = bx; g < SG; g += Gn) build_ssm(a, 1, g, lds, tid);
            break;
        default: is_gemm = false;
            for (int m = gw; m < T; m += NGW) { f32x4 v[4]; rms_row(xres + (size_t)m * D, a.in[23], lane, v); f32x4* o = (f32x4*)(xres + (size_t)m * D) + lane;
#pragma unroll
                for (int jj = 0; jj < 4; ++jj) o[64 * jj] = v[jj]; }
            do_sync = false; break;
        }
        S.nwg = S.nM * S.nN;
        if (is_gemm) pg8::gemm_phase<pg8::Epi, pg8::Order, true, true>(lds, lda, ldb, K, S, E, tid);
        if (do_sync) {
            __builtin_amdgcn_fence(__ATOMIC_RELEASE, "agent"); asm volatile("s_waitcnt vmcnt(0)" ::: "memory");
            grid.sync();
            __builtin_amdgcn_fence(__ATOMIC_ACQUIRE, "agent"); asm volatile("s_waitcnt vmcnt(0)" ::: "memory");
        }
    }
}

extern "C" void kernel_launch(void* const* d_in, const int* in_sizes, int n_in, void* d_out, int out_size, void* d_ws, size_t ws_size, hipStream_t stream) {
    static int grid = 0;
    if (grid == 0) {
        if (n_in != 24 || out_size != T * D || ws_size < WS_END) { fprintf(stderr, "kernel_launch: unexpected shapes (n_in %d out %d ws %zu)\n", n_in, out_size, ws_size); grid = -1; return; }
        int dev = 0, cus = 0, per_cu = 0;
        (void)hipGetDevice(&dev); (void)hipDeviceGetAttribute(&cus, hipDeviceAttributeMultiprocessorCount, dev);
        if (hipFuncSetAttribute((const void*)mega_fwd, hipFuncAttributeMaxDynamicSharedMemorySize, LDS_BYTES) != hipSuccess) { fprintf(stderr, "kernel_launch: hipFuncSetAttribute failed\n"); grid = -1; return; }
        if (hipOccupancyMaxActiveBlocksPerMultiprocessor(&per_cu, (const void*)mega_fwd, NTHR, LDS_BYTES) != hipSuccess || per_cu < 1) { (void)hipGetLastError(); per_cu = 1; }
        grid = cus * per_cu;
        fprintf(stderr, "kernel_launch: %d CUs x %d blocks/CU\n", cus, per_cu);
    }
    if (grid < 0) return;
    Args a{};
    for (int i = 0; i < 24; ++i) a.in[i] = (const float*)d_in[i];
    a.out = (float*)d_out; a.ws = (unsigned char*)d_ws;
    void* kargs[] = {&a};
    hipError_t e = hipLaunchCooperativeKernel((const void*)mega_fwd, dim3(grid), dim3(NTHR), kargs, LDS_BYTES, stream);
    if (e != hipSuccess) fprintf(stderr, "kernel_launch: cooperative launch failed: %s (grid %d)\n", hipGetErrorString(e), grid);
}
```

```cpp
#include <hip/hip_runtime.h>
#include <hip/hip_cooperative_groups.h>
#include <cstdio>
#include <cstdint>
namespace cg = cooperative_groups;

namespace pg8 {
#define PG8_LAS __attribute__((address_space(3)))
typedef unsigned short bf16_t;
typedef short bf16x8 __attribute__((ext_vector_type(8)));
typedef float f32x4 __attribute__((ext_vector_type(4)));
typedef unsigned u32x4 __attribute__((ext_vector_type(4)));
typedef unsigned u32x2 __attribute__((ext_vector_type(2)));
constexpr int BM = 256, BK = 64, HALF = 128, HTB = HALF * BK * 2  , STAGE_BYTES = 8 * HTB, NXCD = 8, WGM = 8;

__host__ __device__ __forceinline__ int lds_byte(int r, int c) { const int st = (r >> 4) * 2 + (c >> 5), rr = r & 15, cc = c & 31, ob = rr * 64 + cc * 2; return st * 1024 + (ob ^ (((ob >> 9) & 1) << 5)); }
__host__ __device__ __forceinline__ void stage_rc(int b, int& R, int& C) { const int st = b / 1024, sb = b % 1024, swz = sb ^ (((sb >> 9) & 1) << 5); R = (st >> 1) * 16 + swz / 64; C = (st & 1) * 32 + (swz % 64) / 2; }
__host__ __device__ __forceinline__ int perm32(int rho) { const int n = rho >> 4, i = rho & 15; return 8 * (i >> 2) + 4 * n + (i & 3); }

struct Unit { int pm, pn; };

struct Order {
    int nM, nN, nwg, G, c; const char* A; const char* B; long am, an, bn, bb, bg;
    __device__ __forceinline__ bool next(int i, Unit& u) const {
        const long L = (long)i * G + c; if (L >= nwg) return false;
        int wgid = (int)L; { const int q = nwg / NXCD, r = nwg % NXCD, xcd = wgid % NXCD, off = wgid / NXCD; wgid = (xcd < r ? xcd * (q + 1) : r * (q + 1) + (xcd - r) * q) + off; }
        const int nig = WGM * nN, gid = wgid / nig, fm = gid * WGM, gsz = (nM - fm) < WGM ? (nM - fm) : WGM;
        u.pm = fm + ((wgid % nig) % gsz); u.pn = (wgid % nig) / gsz; return true;
    }
    __device__ __forceinline__ const char* abase(const Unit& u) const { return A + (long)u.pm * am + (long)u.pn * an; }
    __device__ __forceinline__ const char* bbase(const Unit& u) const { return B + (long)u.pn * bn + (long)(u.pm >> 4) * bb + (long)(u.pm & 63) * bg; }
};

__device__ __forceinline__ unsigned cvt_pk_bf16(float lo, float hi) { unsigned r; asm volatile("v_cvt_pk_bf16_f32 %0, %1, %2" : "=v"(r) : "v"(lo), "v"(hi)); return r; }
__device__ __forceinline__ u32x4 pack8(const f32x4 a, const f32x4 b) { u32x4 w; w.x = cvt_pk_bf16(a[0], a[1]); w.y = cvt_pk_bf16(a[2], a[3]); w.z = cvt_pk_bf16(b[0], b[1]); w.w = cvt_pk_bf16(b[2], b[3]); return w; }
__device__ __forceinline__ float bf_lo(unsigned w) { return __uint_as_float(w << 16); }
__device__ __forceinline__ float bf_hi(unsigned w) { return __uint_as_float(w & 0xffff0000u); }

enum { M_STORE = 0, M_SCALE, M_UP, M_CONVIN, M_RES, M_GLU, M_P, M_O, M_G, M_Y };
__device__ __forceinline__ float gelu_tanh(float y) {
    const float z = 0.7978845608f * (y + 0.044715f * y * y * y);
    const float e = __builtin_amdgcn_exp2f(z * 2.8853900818f);
    const float t = 1.0f - 2.0f * __builtin_amdgcn_rcpf(1.0f + e);
    return 0.5f * y * (1.0f + t);
}
struct Epi {
    static constexpr bool PERM = true;
    int mode, ldc; float mul;
    bf16_t* o0; bf16_t* o1; const float* f0; const float* f1; float* f2; const bf16_t* b0;
    const unsigned long long* sin; unsigned long long* sout;
    __device__ __forceinline__ void operator()(const f32x4 (&acc)[2][2][4][2], const Unit& u, int wr, int wc, int fr, int fq) const {
        const int r0 = u.pm * 256 + wr * 64 + fr;
        const int cw = wc * 32 + 8 * fq;
        if (mode == M_STORE || mode == M_SCALE || mode == M_UP) {
#pragma unroll
            for (int ai = 0; ai < 2; ++ai)
#pragma unroll
                for (int m = 0; m < 4; ++m) { const int row = r0 + ai * 128 + m * 16; float rs = 1.0f;
                    if (mode != M_STORE) rs = __builtin_amdgcn_rsqf((float)sin[row] * (1.0f / (1024.0f * 1048576.0f)) + 1e-6f) * mul;
                    bf16_t* rowp = o0 + (size_t)row * ldc + u.pn * 256 + cw;
#pragma unroll
                    for (int bj = 0; bj < 2; ++bj) { f32x4 v0 = acc[ai][bj][m][0] * rs, v1 = acc[ai][bj][m][1] * rs;
                        if (mode == M_UP) {
#pragma unroll
                            for (int j = 0; j < 4; ++j) { const float a = fmaxf(v0[j], 0.f), b = fmaxf(v1[j], 0.f); v0[j] = a * a; v1[j] = b * b; } }
                        *(u32x4*)(rowp + bj * 128) = pack8(v0, v1); } }
        } else if (mode == M_CONVIN) {
#pragma unroll
            for (int ai = 0; ai < 2; ++ai)
#pragma unroll
                for (int m = 0; m < 4; ++m) { const int row = r0 + ai * 128 + m * 16;
                    const float rs = __builtin_amdgcn_rsqf((float)sin[row] * (1.0f / (1024.0f * 1048576.0f)) + 1e-6f);
                    if (u.pn < 4) { bf16_t* rowp = o0 + (size_t)row * 1024 + u.pn * 256 + cw;
#pragma unroll
                        for (int bj = 0; bj < 2; ++bj) *(u32x4*)(rowp + bj * 128) = pack8(acc[ai][bj][m][0] * rs, acc[ai][bj][m][1] * rs);
                    } else { bf16_t* rowp = o1 + (size_t)row * 1024 + (u.pn - 4) * 128 + cw; const float r2 = rs * rs;
                        *(u32x4*)rowp = pack8(acc[ai][0][m][0] * acc[ai][1][m][0] * r2, acc[ai][0][m][1] * acc[ai][1][m][1] * r2); } }
        } else if (mode == M_RES) {
#pragma unroll
            for (int ai = 0; ai < 2; ++ai)
#pragma unroll
                for (int m = 0; m < 4; ++m) { const int row = r0 + ai * 128 + m * 16; const size_t off = (size_t)row * 1024 + u.pn * 256 + cw; float ssq = 0.f;
#pragma unroll
                    for (int bj = 0; bj < 2; ++bj) { const f32x4 x0 = *(const f32x4*)(f0 + off + bj * 128), x1 = *(const f32x4*)(f0 + off + bj * 128 + 4);
                        const f32x4 v0 = acc[ai][bj][m][0] + x0, v1 = acc[ai][bj][m][1] + x1;
                        *(f32x4*)(f2 + off + bj * 128) = v0; *(f32x4*)(f2 + off + bj * 128 + 4) = v1;
                        ssq += (v0[0] * v0[0] + v0[1] * v0[1]) + (v0[2] * v0[2] + v0[3] * v0[3]) + (v1[0] * v1[0] + v1[1] * v1[1]) + (v1[2] * v1[2] + v1[3] * v1[3]);
                        if (o0) { const f32x4 g0 = *(const f32x4*)(f1 + u.pn * 256 + bj * 128 + cw), g1 = *(const f32x4*)(f1 + u.pn * 256 + bj * 128 + cw + 4); *(u32x4*)(o0 + off + bj * 128) = pack8(v0 * g0, v1 * g1); } }
                    if (sout) { ssq += __shfl_xor(ssq, 16); ssq += __shfl_xor(ssq, 32); if (fq == 0) atomicAdd(sout + row, (unsigned long long)(ssq * 1048576.0f + 0.5f)); } }
        } else if (mode == M_GLU) {
            f32x4 g[2];
#pragma unroll
            for (int n = 0; n < 2; ++n) g[n] = *(const f32x4*)(f1 + u.pn * 128 + cw + 4 * n);
#pragma unroll
            for (int ai = 0; ai < 2; ++ai)
#pragma unroll
                for (int m = 0; m < 4; ++m) { const int row = r0 + ai * 128 + m * 16; const size_t off = (size_t)row * 1024 + u.pn * 128 + cw;
                    f32x4 v[2]; float ssq = 0.f;
#pragma unroll
                    for (int n = 0; n < 2; ++n) { const f32x4 x = *(const f32x4*)(f0 + off + 4 * n); const f32x4 val = acc[ai][0][m][n], gate = acc[ai][1][m][n];
#pragma unroll
                        for (int j = 0; j < 4; ++j) { const float sg = __builtin_amdgcn_rcpf(1.0f + __builtin_amdgcn_exp2f(-1.4426950409f * gate[j])); v[n][j] = x[j] + val[j] * sg; ssq += v[n][j] * v[n][j]; }
                        *(f32x4*)(f2 + off + 4 * n) = v[n]; }
                    *(u32x4*)(o0 + off) = pack8(v[0] * g[0], v[1] * g[1]);
                    ssq += __shfl_xor(ssq, 16); ssq += __shfl_xor(ssq, 32); if (fq == 0) atomicAdd(sout + row, (unsigned long long)(ssq * 1048576.0f + 0.5f)); }
        } else if (mode == M_P) {
#pragma unroll
            for (int ai = 0; ai < 2; ++ai)
#pragma unroll
                for (int m = 0; m < 4; ++m) { const int row = r0 + ai * 128 + m * 16; bf16_t* rowp = o0 + (size_t)row * 1024 + u.pn * 256 + cw; float s = 0.f;
#pragma unroll
                    for (int bj = 0; bj < 2; ++bj) { f32x4 v0, v1;
#pragma unroll
                        for (int j = 0; j < 4; ++j) { v0[j] = __builtin_amdgcn_exp2f(acc[ai][bj][m][0][j]); v1[j] = __builtin_amdgcn_exp2f(acc[ai][bj][m][1][j]); s += v0[j] + v1[j]; }
                        *(u32x4*)(rowp + bj * 128) = pack8(v0, v1); }
                    s += __shfl_xor(s, 16); s += __shfl_xor(s, 32); if (fq == 0) atomicAdd(sout + (size_t)row * 4 + u.pn, (unsigned long long)(s * 65536.0f + 0.5f)); }
        } else if (mode == M_O) {
#pragma unroll
            for (int ai = 0; ai < 2; ++ai)
#pragma unroll
                for (int m = 0; m < 4; ++m) { const int row = r0 + ai * 128 + m * 16; const float inv = 65536.0f / (float)sin[(size_t)row * 4 + u.pn];
                    bf16_t* rowp = o0 + (size_t)row * 1024 + u.pn * 256 + cw;
#pragma unroll
                    for (int bj = 0; bj < 2; ++bj) *(u32x4*)(rowp + bj * 128) = pack8(acc[ai][bj][m][0] * inv, acc[ai][bj][m][1] * inv); }
        } else if (mode == M_G) {
#pragma unroll
            for (int ai = 0; ai < 2; ++ai)
#pragma unroll
                for (int m = 0; m < 4; ++m) { float* p = f2 + (size_t)(r0 + ai * 128 + m * 16) * 128 + cw;
                    *(f32x4*)p = acc[ai][0][m][0]; *(f32x4*)(p + 4) = acc[ai][0][m][1]; }
        } else {
            const int b = u.pm >> 6, g = u.pm & 63, ho0 = (fq & 1) * 8;
            const f32x4 d0 = *(const f32x4*)(f1 + g * 16 + ho0), d1 = *(const f32x4*)(f1 + g * 16 + ho0 + 4);
#pragma unroll
            for (int ai = 0; ai < 2; ++ai)
#pragma unroll
                for (int m = 0; m < 4; ++m) { const int c = ai * 128 + wr * 64 + m * 16 + fr;
#pragma unroll
                    for (int bj = 0; bj < 2; ++bj) { const int jt = bj * 8 + wc * 2 + (fq >> 1);
                        const u32x4 uw = *(const u32x4*)(b0 + ((size_t)u.pm * 256 + c) * 384 + jt * 16 + ho0);
                        f32x4 v0 = acc[ai][bj][m][0], v1 = acc[ai][bj][m][1];
                        v0[0] += d0[0] * bf_lo(uw.x); v0[1] += d0[1] * bf_hi(uw.x); v0[2] += d0[2] * bf_lo(uw.y); v0[3] += d0[3] * bf_hi(uw.y);
                        v1[0] += d1[0] * bf_lo(uw.z); v1[1] += d1[1] * bf_hi(uw.z); v1[2] += d1[2] * bf_lo(uw.w); v1[3] += d1[3] * bf_hi(uw.w);
#pragma unroll
                        for (int j = 0; j < 4; ++j) { v0[j] = gelu_tanh(v0[j]); v1[j] = gelu_tanh(v1[j]); }
                        *(u32x4*)(o0 + ((size_t)b * 4096 + c * 16 + jt) * 1024 + g * 16 + ho0) = pack8(v0, v1); } }
        }
    }
};

template <class Epi, class Sched, bool ALIGN_EPI = false, bool SP2 = false>
__device__ __forceinline__ void gemm_phase(PG8_LAS unsigned char* lds, const int lda, const int ldb, const int K, const Sched& S, const Epi& E, const int tid) {
    const int wid = __builtin_amdgcn_readfirstlane(tid >> 6), lane = tid & 63, wr = wid >> 2, wc = wid & 3, fr = lane & 15, fq = lane >> 4;
    const int nt = K / BK;
    unsigned voffA[2], voffB[2];
#pragma unroll
    for (int i = 0; i < 2; ++i) { int R, C; stage_rc(tid * 16 + i * 8192, R, C); const int Rb = Epi::PERM ? ((R & ~31) + perm32(R & 31)) : R;
        voffA[i] = (unsigned)(R * lda + C) * 2u; voffB[i] = (unsigned)(Rb * ldb + C) * 2u; }
    const size_t kstep = (size_t)(BK * 2);
    const size_t hstepA = (size_t)HALF * lda * 2, hstepB = (size_t)HALF * ldb * 2;
    const unsigned ldsw = (unsigned)wid * 1024u;
    const int aoff = lds_byte(wr * 64 + fr, fq * 8), boff = lds_byte(wc * 32 + fr, fq * 8);
#define PG8_SA(b, h) (((b) * 2 + (h)) * HTB)
#define PG8_SB(b, h) ((4 + (b) * 2 + (h)) * HTB)
#define PG8_STAGE(bufoff, gbase, voff) do { _Pragma("unroll") for (int _i = 0; _i < 2; ++_i) \
        __builtin_amdgcn_global_load_lds((const unsigned*)((const char*)(gbase) + (voff)[_i]), (PG8_LAS unsigned*)(lds + (bufoff) + ldsw + _i * 8192), 16, 0, 0); } while (0)
#define PG8_LDA(dst, b, h) do { _Pragma("unroll") for (int m = 0; m < 4; ++m) _Pragma("unroll") for (int k = 0; k < 2; ++k) dst[m][k] = *(const PG8_LAS bf16x8*)(lds + PG8_SA(b, h) + aoff + m * 2048 + k * 1024); } while (0)
#define PG8_LDB(dst, b, h) do { _Pragma("unroll") for (int n = 0; n < 2; ++n) _Pragma("unroll") for (int k = 0; k < 2; ++k) dst[n][k] = *(const PG8_LAS bf16x8*)(lds + PG8_SB(b, h) + boff + n * 2048 + k * 1024); } while (0)
#define PG8_MMA(ai, bj, At, Bt) do { __builtin_amdgcn_s_setprio(1); _Pragma("unroll") for (int m = 0; m < 4; ++m) _Pragma("unroll") for (int n = 0; n < 2; ++n) _Pragma("unroll") for (int k = 0; k < 2; ++k) \
        acc[ai][bj][m][n] = __builtin_amdgcn_mfma_f32_16x16x32_bf16(Bt[n][k], At[m][k], acc[ai][bj][m][n], 0, 0, 0); __builtin_amdgcn_s_setprio(0); } while (0)
#define PG8_WAIT_V(n) asm volatile("s_waitcnt vmcnt(" #n ")" ::: "memory")
#define PG8_WAIT_L(n) asm volatile("s_waitcnt lgkmcnt(" #n ")" ::: "memory")
#define PG8_BAR __builtin_amdgcn_s_barrier()
#define PG8_SCHED __builtin_amdgcn_sched_barrier(0)
    Unit cur, nxt; int ui = 0;
    if (!S.next(0, cur)) return;
    f32x4 acc[2][2][4][2];
#pragma unroll
    for (int a = 0; a < 2; ++a)
#pragma unroll
        for (int b = 0; b < 2; ++b)
#pragma unroll
            for (int m = 0; m < 4; ++m)
#pragma unroll
                for (int n = 0; n < 2; ++n) acc[a][b][m][n] = (f32x4){0.f, 0.f, 0.f, 0.f};
    bf16x8 At[4][2], B0[2][2], B1[2][2];
    const char* cA = S.abase(cur); const char* cB = S.bbase(cur);
    if constexpr (SP2) {
        PG8_STAGE(PG8_SB(0, 0), cB, voffB); PG8_STAGE(PG8_SB(0, 1), cB + hstepB, voffB); PG8_STAGE(PG8_SA(0, 0), cA, voffA); PG8_STAGE(PG8_SA(0, 1), cA + hstepA, voffA);
        if (wr == 1) PG8_BAR;
        PG8_WAIT_V(2); PG8_BAR;
        PG8_STAGE(PG8_SB(1, 0), cB + kstep, voffB); PG8_STAGE(PG8_SA(1, 0), cA + kstep, voffA); PG8_STAGE(PG8_SB(1, 1), cB + hstepB + kstep, voffB);
        PG8_WAIT_V(6); PG8_BAR;
    } else {
        PG8_STAGE(PG8_SB(0, 0), cB, voffB); PG8_STAGE(PG8_SA(0, 0), cA, voffA); PG8_STAGE(PG8_SB(0, 1), cB + hstepB, voffB); PG8_STAGE(PG8_SA(0, 1), cA + hstepA, voffA);
        if (wr == 1) PG8_BAR;
        PG8_WAIT_V(4); PG8_BAR;
        PG8_STAGE(PG8_SB(1, 0), cB + kstep, voffB); PG8_STAGE(PG8_SA(1, 0), cA + kstep, voffA); PG8_STAGE(PG8_SB(1, 1), cB + hstepB + kstep, voffB);
        PG8_WAIT_V(6); PG8_BAR;
    }
    for (;;) {
        const bool has_next = S.next(ui + 1, nxt);
        const char* nA = has_next ? S.abase(nxt) : cA; const char* nB = has_next ? S.bbase(nxt) : cB;
        for (int t = 0; t < nt; t += 2) {
            const bool last = (t == nt - 2);
            const char* a1 = cA + (size_t)(t + 1) * kstep;
            const char* a2 = last ? nA : cA + (size_t)(t + 2) * kstep; const char* b2 = last ? nB : cB + (size_t)(t + 2) * kstep;
            const char* a3 = a2 + kstep; const char* b3 = b2 + kstep;
            if constexpr (SP2) {
            PG8_LDB(B0, 0, 0); PG8_LDB(B1, 0, 1); PG8_SCHED; PG8_LDA(At, 0, 0); PG8_STAGE(PG8_SA(1, 1), a1 + hstepA, voffA);
            PG8_WAIT_V(8); PG8_WAIT_L(0); PG8_BAR; PG8_MMA(0, 0, At, B0); PG8_MMA(0, 1, At, B1); PG8_BAR; PG8_SCHED;
            PG8_LDA(At, 0, 1); PG8_STAGE(PG8_SB(0, 0), b2, voffB); PG8_STAGE(PG8_SB(0, 1), b2 + hstepB, voffB); PG8_STAGE(PG8_SA(0, 0), a2, voffA);
            PG8_WAIT_V(8); PG8_WAIT_L(0); PG8_BAR; PG8_MMA(1, 0, At, B0); PG8_MMA(1, 1, At, B1); PG8_BAR; PG8_SCHED;
            PG8_LDB(B0, 1, 0); PG8_LDB(B1, 1, 1); PG8_SCHED; PG8_LDA(At, 1, 0); PG8_STAGE(PG8_SA(0, 1), a2 + hstepA, voffA);
            PG8_WAIT_V(8); PG8_WAIT_L(0); PG8_BAR; PG8_MMA(0, 0, At, B0); PG8_MMA(0, 1, At, B1); PG8_BAR; PG8_SCHED;
            PG8_LDA(At, 1, 1); PG8_STAGE(PG8_SB(1, 0), b3, voffB); PG8_STAGE(PG8_SB(1, 1), b3 + hstepB, voffB); PG8_STAGE(PG8_SA(1, 0), a3, voffA);
            PG8_WAIT_V(8); PG8_WAIT_L(0); PG8_BAR; PG8_MMA(1, 0, At, B0); PG8_MMA(1, 1, At, B1); PG8_BAR; PG8_SCHED;
            } else {
            PG8_LDB(B0, 0, 0); PG8_SCHED; PG8_LDA(At, 0, 0); PG8_STAGE(PG8_SA(1, 1), a1 + hstepA, voffA);
            PG8_WAIT_L(8); PG8_BAR; PG8_WAIT_L(0); PG8_MMA(0, 0, At, B0); PG8_BAR; PG8_SCHED;
            PG8_LDB(B1, 0, 1); PG8_STAGE(PG8_SB(0, 0), b2, voffB);
            PG8_BAR; PG8_WAIT_L(0); PG8_MMA(0, 1, At, B1); PG8_BAR;
            PG8_LDA(At, 0, 1); PG8_STAGE(PG8_SA(0, 0), a2, voffA);
            PG8_BAR; PG8_WAIT_L(0); PG8_MMA(1, 0, At, B0); PG8_BAR; PG8_SCHED;
            PG8_STAGE(PG8_SB(0, 1), b2 + hstepB, voffB);
            PG8_WAIT_V(6); PG8_BAR; PG8_MMA(1, 1, At, B1); PG8_BAR;
            PG8_LDB(B0, 1, 0); PG8_SCHED; PG8_LDA(At, 1, 0); PG8_STAGE(PG8_SA(0, 1), a2 + hstepA, voffA);
            PG8_WAIT_L(8); PG8_BAR; PG8_WAIT_L(0); PG8_MMA(0, 0, At, B0); PG8_BAR; PG8_SCHED;
            PG8_LDB(B1, 1, 1); PG8_STAGE(PG8_SB(1, 0), b3, voffB);
            PG8_BAR; PG8_WAIT_L(0); PG8_MMA(0, 1, At, B1); PG8_BAR;
            PG8_LDA(At, 1, 1); PG8_STAGE(PG8_SA(1, 0), a3, voffA);
            PG8_BAR; PG8_WAIT_L(0); PG8_MMA(1, 0, At, B0); PG8_BAR; PG8_SCHED;
            PG8_STAGE(PG8_SB(1, 1), b3 + hstepB, voffB);
            PG8_WAIT_V(6); PG8_BAR; PG8_MMA(1, 1, At, B1); PG8_BAR;
            }
        }
        if constexpr (ALIGN_EPI) { if (wr == 0) PG8_BAR; }
        { int frv = fr, fqv = fq; asm volatile("" : "+v"(frv), "+v"(fqv)); E(acc, cur, wr, wc, frv, fqv); }
        if (!has_next) break;
#pragma unroll
        for (int a = 0; a < 2; ++a)
#pragma unroll
            for (int b = 0; b < 2; ++b)
#pragma unroll
                for (int m = 0; m < 4; ++m)
#pragma unroll
                    for (int n = 0; n < 2; ++n) acc[a][b][m][n] = (f32x4){0.f, 0.f, 0.f, 0.f};
        cur = nxt; cA = nA; cB = nB; ++ui;
        if constexpr (ALIGN_EPI) { if (wr == 1) PG8_BAR; }
    }
    PG8_WAIT_V(0);
    if constexpr (!ALIGN_EPI) { if (wr == 0) PG8_BAR; }
    PG8_BAR;
#undef PG8_SA
#undef PG8_SB
#undef PG8_STAGE
#undef PG8_LDA
#undef PG8_LDB
#undef PG8_MMA
#undef PG8_WAIT_V
#undef PG8_WAIT_L
#undef PG8_BAR
#undef PG8_SCHED
}
}
using pg8::bf16_t; using pg8::f32x4; using pg8::u32x4; using pg8::u32x2;
#define LAS __attribute__((address_space(3)))

constexpr int BATCH = 8, SEQ = 4096, D = 1024, T = BATCH * SEQ, DEPTH = 4, NMEM = 256, HEADS = 4, HD = 256, FF = 4096;
constexpr int SG = 64, SP = 64, SH = 16, CL = 16, NCH = SEQ / CL;
constexpr int KX = CL * SH + 2 * SP;
constexpr float EPS = 1e-6f;
constexpr int NWAVES = 8, NTHR = 512;
constexpr int LDS_BYTES = 147456;

constexpr size_t MiB = 1u << 20;
constexpr size_t WS_SS = 0;
constexpr size_t WS_L = 4 * MiB;
constexpr size_t WS_ZERO_BYTES = 8 * MiB;
constexpr size_t WS_TAB = 8 * MiB;
constexpr size_t WS_F = 9 * MiB;
constexpr size_t WS_W2X = 14 * MiB;
constexpr size_t WS_MEMN = 26 * MiB;
constexpr size_t WS_KB = 30 * MiB;
constexpr size_t WS_VT = 46 * MiB;
constexpr size_t WS_WGLU = 62 * MiB, WS_WIN = 70 * MiB, WS_WOUT = 82 * MiB, WS_WQ = 86 * MiB, WS_WK = 94 * MiB, WS_WV = 102 * MiB, WS_WO = 110 * MiB, WS_W1 = 118 * MiB, WS_W2 = 150 * MiB;
constexpr size_t WS_XG = 182 * MiB;
constexpr size_t WS_BIG = 246 * MiB;
constexpr size_t WS_BAR = 502 * MiB;
constexpr size_t WS_END = 503 * MiB;
constexpr size_t BG_H = 0, BG_Q = 0, BG_P = 64 * MiB, BG_BC = 0, BG_Z = 64 * MiB, BG_UC = 128 * MiB, BG_UEXT = 0, BG_G = 96 * MiB, BG_Y = 160 * MiB;

struct Args { const float* in[24]; float* out; unsigned char* ws; };

__device__ __forceinline__ float wave_sum(float v) {
#pragma unroll
    for (int o = 1; o < 64; o <<= 1) v += __shfl_xor(v, o);
    return v;
}
__device__ __forceinline__ unsigned f2bf(float f) { unsigned u = __float_as_uint(f); return (u + 0x7fffu + ((u >> 16) & 1u)) >> 16; }
__device__ __forceinline__ unsigned pk2(float lo, float hi) { return f2bf(lo) | (f2bf(hi) << 16); }

__device__ __forceinline__ void transpose_item(const float* W, int K, int N, bf16_t* drow0, int k0, int n0, LAS float* scr, int lane) {
#pragma unroll 8
    for (int i = 0; i < 32; ++i) { const int kk = 2 * i + (lane >> 5); scr[kk * 33 + (lane & 31)] = W[(size_t)(k0 + kk) * N + n0 + (lane & 31)]; }
    asm volatile("s_waitcnt lgkmcnt(0)" ::: "memory");
    const int c = lane & 7;
#pragma unroll
    for (int j = 0; j < 4; ++j) { const int n = (lane >> 3) + 8 * j; const LAS float* s = scr + (8 * c) * 33 + n;
        u32x4 o; o.x = pk2(s[0 * 33], s[1 * 33]); o.y = pk2(s[2 * 33], s[3 * 33]); o.z = pk2(s[4 * 33], s[5 * 33]); o.w = pk2(s[6 * 33], s[7 * 33]);
        *(u32x4*)(drow0 + (size_t)n * K + k0 + 8 * c) = o; }
    asm volatile("s_waitcnt lgkmcnt(0)" ::: "memory");
}

__device__ __forceinline__ void rms_row(const float* xrow, const float* gain, int lane, f32x4 (&v)[4]) {
    const f32x4* xr = (const f32x4*)xrow + lane; const f32x4* gr = (const f32x4*)gain + lane; float s = 0.f;
#pragma unroll
    for (int j = 0; j < 4; ++j) { v[j] = xr[64 * j]; s += (v[j][0] * v[j][0] + v[j][1] * v[j][1]) + (v[j][2] * v[j][2] + v[j][3] * v[j][3]); }
    const float rstd = 1.0f / sqrtf(wave_sum(s) * (1.0f / D) + EPS);
#pragma unroll
    for (int j = 0; j < 4; ++j) v[j] = v[j] * rstd * gr[64 * j];
}

__device__ __forceinline__ void norm_chunk_to_uext(const float* x, const float* gain, bf16_t* uext, int ci, LAS unsigned char* lds, int wave, int lane) {
    const int b = ci >> 8, c = ci & 255; const size_t t0 = (size_t)b * SEQ + c * CL;
    constexpr int PITCH = 2064;
#pragma unroll
    for (int r = 0; r < 2; ++r) { const int tok = r * 8 + wave; f32x4 v[4]; rms_row(x + (t0 + tok) * D, gain, lane, v);
#pragma unroll
        for (int j = 0; j < 4; ++j) { u32x2 w; w.x = pk2(v[j][0], v[j][1]); w.y = pk2(v[j][2], v[j][3]); *(LAS u32x2*)(lds + tok * PITCH + (4 * lane + 256 * j) * 2) = w; } }
    __syncthreads();
    const int l32 = lane & 31, tk = l32 >> 1, half = l32 & 1;
#pragma unroll
    for (int gi = 0; gi < 8; gi += 2) { const int g = wave * 8 + gi + (lane >> 5);
        const u32x4 w = *(const LAS u32x4*)(lds + tk * PITCH + (g * 16 + half * 8) * 2);
        *(u32x4*)(uext + ((size_t)(b * 64 + g) * 256 + c) * KX + tk * 16 + half * 8) = w; }
    __syncthreads();
}

struct SsmIn { const float *a_re, *a_im, *log_dt, *b_re, *b_im, *c_re, *c_im; unsigned char* ws; };
__device__ __forceinline__ void build_ssm(const SsmIn& a, int j, int g, LAS unsigned char* lds, int tid) {
    typedef float f32x2 __attribute__((ext_vector_type(2)));
    LAS f32x2* pw = (LAS f32x2*)lds;
    LAS f32x2* bb = (LAS f32x2*)(lds + 8704);
    LAS f32x2* cc = (LAS f32x2*)(lds + 16896);
    LAS float* kk = (LAS float*)(lds + 25088);
    const float* a_re = a.a_re + (size_t)(j * SG + g) * SP; const float* a_im = a.a_im + (size_t)(j * SG + g) * SP;
    const float dt = expf(a.log_dt[j * SG + g]);
    const float* b_re = a.b_re + (size_t)(j * SG + g) * SP * SH; const float* b_im = a.b_im + (size_t)(j * SG + g) * SP * SH;
    const float* c_re = a.c_re + (size_t)(j * SG + g) * SH * SP; const float* c_im = a.c_im + (size_t)(j * SG + g) * SH * SP;
    if (tid < 64) { const float are = a_re[tid], aim = a_im[tid];
        for (int k = 0; k <= 16; ++k) { const float mag = expf(are * dt * (float)k); double ang = (double)aim * (double)dt * (double)k; ang -= 6.283185307179586 * rint(ang * 0.15915494309189535);
            float sn, cs; sincosf((float)ang, &sn, &cs); pw[k * 64 + tid] = (f32x2){mag * cs, mag * sn}; }
        const float mag = expf(are * dt * 1024.0f); double ang = (double)aim * (double)dt * 1024.0; ang -= 6.283185307179586 * rint(ang * 0.15915494309189535);
        float sn, cs; sincosf((float)ang, &sn, &cs);
        f32x4 t; t[0] = pw[16 * 64 + tid].x; t[1] = pw[16 * 64 + tid].y; t[2] = mag * cs; t[3] = mag * sn;
        *(f32x4*)(a.ws + WS_TAB + ((size_t)g * 64 + tid) * 16) = t; }
    __syncthreads();
    for (int idx = tid; idx < 1024; idx += NTHR) { const int p = idx >> 4;
        const float are = a_re[p], aim = a_im[p]; const f32x2 ab = pw[64 + p];
        const float nr = ab.x - 1.0f, ni = ab.y, den = 1.0f / (are * are + aim * aim);
        const float qr = (nr * are + ni * aim) * den, qi = (ni * are - nr * aim) * den;
        const float br = b_re[idx], bi = b_im[idx];
        bb[idx] = (f32x2){qr * br - qi * bi, qr * bi + qi * br};
        cc[idx] = (f32x2){c_re[idx], c_im[idx]}; }
    __syncthreads();
    for (int idx = tid; idx < 4096; idx += NTHR) { const int k = idx >> 8, ho = (idx >> 4) & 15, hi = idx & 15; float s = 0.f;
        for (int p = 0; p < 64; ++p) { const f32x2 c = cc[ho * 64 + p], w = pw[k * 64 + p], bq = bb[p * 16 + hi];
            const float tr = c.x * w.x - c.y * w.y, ti = c.x * w.y + c.y * w.x; s += tr * bq.x - ti * bq.y; }
        kk[idx] = s; }
    __syncthreads();
    unsigned* w2 = (unsigned*)(a.ws + WS_W2X) + (size_t)g * 256 * (KX / 2);
    for (int idx = tid; idx < 256 * (KX / 2); idx += NTHR) { const int n = idx / (KX / 2), kc = (idx % (KX / 2)) * 2, jt = n >> 4, ho = n & 15; float v0, v1;
        if (kc < 256) { const int i = kc >> 4, hi = kc & 15; if (i <= jt) { v0 = kk[((jt - i) * 16 + ho) * 16 + hi]; v1 = kk[((jt - i) * 16 + ho) * 16 + hi + 1]; } else { v0 = 0.f; v1 = 0.f; } }
        else { const int p = (kc - 256) & 63; const f32x2 c0 = cc[ho * 64 + p], c1 = cc[ho * 64 + p + 1], w0 = pw[(jt + 1) * 64 + p], w1 = pw[(jt + 1) * 64 + p + 1];
            if (kc < 320) { v0 = c0.x * w0.x - c0.y * w0.y; v1 = c1.x * w1.x - c1.y * w1.y; } else { v0 = -(c0.x * w0.y + c0.y * w0.x); v1 = -(c1.x * w1.y + c1.y * w1.x); } }
        w2[idx] = pk2(v0, v1); }
    unsigned* fm = (unsigned*)(a.ws + WS_F) + (size_t)g * 128 * 128;
    for (int idx = tid; idx < 128 * 128; idx += NTHR) { const int n = idx >> 7, kc = (idx & 127) * 2, p = n & 63, i = kc >> 4, hi = kc & 15;
        const f32x2 w = pw[(15 - i) * 64 + p], q0 = bb[p * 16 + hi], q1 = bb[p * 16 + hi + 1]; float v0, v1;
        if (n < 64) { v0 = w.x * q0.x - w.y * q0.y; v1 = w.x * q1.x - w.y * q1.y; } else { v0 = w.x * q0.y + w.y * q0.x; v1 = w.x * q1.y + w.y * q1.x; }
        fm[idx] = pk2(v0, v1); }
    __syncthreads();
}

__device__ __forceinline__ void ssm_scan(unsigned char* ws_, LAS unsigned char* lds, const pg8::Order& S, int wave, int lane) {
    struct { unsigned char* ws; } a; a.ws = ws_;
    typedef float f32x2 __attribute__((ext_vector_type(2)));
    LAS f32x2* ex = (LAS f32x2*)lds;
    const float* Gb = (const float*)(a.ws + WS_BIG + BG_G); bf16_t* ue = (bf16_t*)(a.ws + WS_BIG + BG_UEXT);
    for (int i = 0; ; i += 2) {
        pg8::Unit u0, u1; if (!S.next(i, u0)) break; const bool has1 = S.next(i + 1, u1);
        const int bg = (wave >> 2) ? (has1 ? u1.pm : u0.pm) : u0.pm, seg = wave & 3, g = bg & 63, p = lane; const bool live = (wave >> 2) == 0 || has1;
        const f32x4 tb = *(const f32x4*)(a.ws + WS_TAB + ((size_t)g * 64 + p) * 16);
        const float* gp = Gb + ((size_t)bg * 256 + seg * 64) * 128 + p;
        float er = 0.f, ei = 0.f;
        for (int c0 = 0; c0 < 64; c0 += 16) { float gr[16], gi[16];
#pragma unroll
            for (int k = 0; k < 16; ++k) { gr[k] = gp[(size_t)(c0 + k) * 128]; gi[k] = gp[(size_t)(c0 + k) * 128 + 64]; }
#pragma unroll
            for (int k = 0; k < 16; ++k) { const float nr = tb[0] * er - tb[1] * ei + gr[k], ni = tb[0] * ei + tb[1] * er + gi[k]; er = nr; ei = ni; } }
        ex[wave * 64 + p] = (f32x2){er, ei};
        __syncthreads();
        float sr = 0.f, si = 0.f;
        for (int s = 0; s < seg; ++s) { const f32x2 e = ex[((wave & 4) + s) * 64 + p]; const float nr = tb[2] * sr - tb[3] * si + e.x, ni = tb[2] * si + tb[3] * sr + e.y; sr = nr; si = ni; }
        bf16_t* up = ue + ((size_t)bg * 256 + seg * 64) * KX + 256 + p;
        for (int c0 = 0; c0 < 64; c0 += 16) { float gr[16], gi[16];
#pragma unroll
            for (int k = 0; k < 16; ++k) { gr[k] = gp[(size_t)(c0 + k) * 128]; gi[k] = gp[(size_t)(c0 + k) * 128 + 64]; }
#pragma unroll
            for (int k = 0; k < 16; ++k) { if (live) { up[(size_t)(c0 + k) * KX] = (bf16_t)f2bf(sr); up[(size_t)(c0 + k) * KX + 64] = (bf16_t)f2bf(si); }
                const float nr = tb[0] * sr - tb[1] * si + gr[k], ni = tb[0] * si + tb[1] * sr + gi[k]; sr = nr; si = ni; } }
        __syncthreads();
    }
}

#define XB_TMO      128
#define XB_XCNT(j)  (256  + 64 * (j))
#define XB_XSUB(j)  (1280 + 64 * (j))
#define XB_XGEN(j)  (2304 + 64 * (j))
#define XB_TOP      3328
#define XB_TOPGEN   3392
#define XCD_BAR_WORDS 3456
#define XB_SPIN_CAP (1u << 22)
__device__ __forceinline__ unsigned xb_ld(unsigned* p)              { return __hip_atomic_load(p, __ATOMIC_RELAXED, __HIP_MEMORY_SCOPE_AGENT); }
__device__ __forceinline__ unsigned xb_add(unsigned* p, unsigned v) { return __hip_atomic_fetch_add(p, v, __ATOMIC_RELAXED, __HIP_MEMORY_SCOPE_AGENT); }
__device__ __forceinline__ unsigned xb_xcc_id() { return (unsigned)__builtin_amdgcn_s_getreg((3 << 11) | 20) & 0xFu; }
#define XB_SPIN(cond, bar) do { unsigned _sp = 0; while (cond) { __builtin_amdgcn_s_sleep(1); \
    if ((++_sp & 255u) == 0u) { if (xb_ld(&(bar)[XB_TMO])) break; if (_sp > XB_SPIN_CAP) { atomicAdd(&(bar)[XB_TMO], 1u); break; } } } } while (0)
struct XcdBarrier { unsigned* bar; unsigned x; volatile LAS unsigned* st; };
__device__ __forceinline__ XcdBarrier xcd_barrier_post(unsigned* bar, volatile LAS unsigned* st) {
    XcdBarrier b; b.bar = bar; b.x = xb_xcc_id(); b.st = st;
    if (threadIdx.x == 0) (void)xb_add(&bar[XB_XCNT(b.x)], 1u);
    return b;
}
__device__ __forceinline__ void xcd_barrier_complete(unsigned* bar, unsigned x, unsigned& nloc, unsigned& nx) {
    const unsigned G = gridDim.x * gridDim.y * gridDim.z;
    unsigned sum, cnt, mine, sp = 0u;
    for (;;) {
        sum = 0u; cnt = 0u; mine = 0u;
#pragma unroll
        for (unsigned j = 0; j < 16; ++j) { const unsigned c = xb_ld(&bar[XB_XCNT(j)]); sum += c; cnt += (c > 0u) ? 1u : 0u; mine = (j == x) ? c : mine; }
        if (sum == G) break;
        __builtin_amdgcn_s_sleep(1);
        if ((++sp & 255u) == 0u) { if (xb_ld(&bar[XB_TMO])) break; if (sp > XB_SPIN_CAP) { atomicAdd(&bar[XB_TMO], 1u); break; } }
    }
    nloc = mine > 0u ? mine : 1u; nx = cnt > 0u ? cnt : 1u;
}
__device__ __forceinline__ void xcd_barrier(const XcdBarrier& b) {
    asm volatile("s_waitcnt vmcnt(0)" ::: "memory");
    __syncthreads();
    if (threadIdx.x == 0) {
        unsigned* bar = b.bar;
        __builtin_amdgcn_s_waitcnt(0);
        unsigned nloc = b.st[0], nx = b.st[1];
        if (nloc == 0u) { xcd_barrier_complete(bar, b.x, nloc, nx); b.st[0] = nloc; b.st[1] = nx; }
        const unsigned old = xb_add(&bar[XB_XSUB(b.x)], 1u);
        const unsigned gen = old / nloc;
        if (old + 1u == (gen + 1u) * nloc) {
            __builtin_amdgcn_fence(__ATOMIC_RELEASE, "agent");
            asm volatile("s_waitcnt vmcnt(0)" ::: "memory");
            const unsigned og = xb_add(&bar[XB_TOP], 1u);
            const unsigned tg = og / nx;
            if (og + 1u == (tg + 1u) * nx) xb_add(&bar[XB_TOPGEN], 1u);
            else XB_SPIN(xb_ld(&bar[XB_TOPGEN]) == tg, bar);
            __builtin_amdgcn_fence(__ATOMIC_ACQUIRE, "agent");
            xb_add(&bar[XB_XGEN(b.x)], 1u);
            asm volatile("s_waitcnt vmcnt(0)" ::: "memory");
        } else {
            XB_SPIN(xb_ld(&bar[XB_XGEN(b.x)]) == gen, bar);
            __builtin_amdgcn_fence(__ATOMIC_ACQUIRE, "agent");
            asm volatile("s_waitcnt vmcnt(0)" ::: "memory");
        }
    }
    __syncthreads();
}

enum { PH_P0 = 0, PH_KVK, PH_KVV, PH_SSM1, PH_SCAN, PH_SSM3, PH_GLU, PH_Q, PH_SP, PH_OV, PH_WO, PH_UP, PH_DOWN, PH_CONVIN, PH_CONV, PH_CONVOUT, PH_NORM2, PH_FINAL };
constexpr int NPROG = 43;
#ifndef PROBE_REP_MASK
#define PROBE_REP_MASK 0u
#endif
#ifndef PROBE_SYNC_REP
#define PROBE_SYNC_REP 1
#endif

__global__ void __launch_bounds__(NTHR, 2) mega_fwd(Args a) {
    extern __shared__ __attribute__((aligned(16))) unsigned char lds_raw[];
    cg::grid_group grid = cg::this_grid();
    LAS unsigned char* lds = (LAS unsigned char*)lds_raw;
    const int Gn = gridDim.x, bx = blockIdx.x, wave0 = __builtin_amdgcn_readfirstlane((int)(threadIdx.x >> 6));
    const int vcu = (Gn % 8 == 0) ? (bx % 8) * (Gn / 8) + bx / 8 : bx;
    const int NGW = Gn * NWAVES;
#define AS4 __attribute__((address_space(4)))
    { unsigned char* ws = a.ws;
    if (threadIdx.x < 8) ((LAS unsigned*)(lds + 131072 + 64))[threadIdx.x] = 0u;
    __syncthreads();
    (void)xcd_barrier_post((unsigned*)(ws + WS_BAR), (volatile LAS unsigned*)(lds + 131072 + 64)); }

#pragma nounroll
    for (int pi = 0; pi < NPROG; ++pi) {
        int ph, l = 0;
        if (pi < 3) ph = pi;
        else { int q = pi - 3;
            if (q == 19) ph = PH_NORM2; else if (q == 39) ph = PH_FINAL;
            else { if (q >= 20) { q -= 20; l = 2; } int r = q; if (q >= 10) { r = q - 10; l += 1; }
                if (l & 1) ph = (r < 3) ? PH_CONVIN + r : PH_Q + (r - 3); else ph = (r < 4) ? PH_SSM1 + r : PH_Q + (r - 4); } }
        const int j = l >> 1;
        const AS4 char* kp = (const AS4 char*)__builtin_amdgcn_kernarg_segment_ptr(); asm volatile("" : "+s"(kp));
#define INP(k) (*(const float* const AS4*)(kp + 8 * (k)))
        unsigned char* const ws = *(unsigned char* const AS4*)(kp + 200);
        float* const xres = *(float* const AS4*)(kp + 192);
        bf16_t* const XG = (bf16_t*)(ws + WS_XG);
        unsigned char* const big = ws + WS_BIG;
        int lanev = (int)__builtin_amdgcn_mbcnt_hi(~0u, __builtin_amdgcn_mbcnt_lo(~0u, 0u)); asm volatile("" : "+v"(lanev));
        const int lane = lanev, wave = wave0, tid = wave * 64 + lane, gw = vcu * NWAVES + wave;
        bool is_gemm = true, do_sync = true, local_seam = false;
        pg8::Order S; pg8::Epi E; int lda = D, ldb = D, K = D;
        S.G = Gn; S.c = bx; S.an = 0; S.bb = 0; S.bg = 0; S.nM = T / 256; S.nN = 4; S.A = nullptr; S.B = nullptr; S.am = 256L * D * 2; S.bn = 256L * D * 2;
        E.mode = pg8::M_STORE; E.ldc = D; E.mul = 1.0f; E.o0 = nullptr; E.o1 = nullptr; E.f0 = nullptr; E.f1 = nullptr; E.f2 = nullptr; E.b0 = nullptr; E.sin = nullptr; E.sout = nullptr;
        unsigned long long* const SSb = (unsigned long long*)(ws + WS_SS); unsigned long long* const Lb = (unsigned long long*)(ws + WS_L) + (size_t)l * T * 4;
        switch (ph) {
        case PH_P0: { is_gemm = false;
            { f32x4* z = (f32x4*)ws; const f32x4 zero = {0.f, 0.f, 0.f, 0.f}; for (int i = bx * NTHR + tid; i < (int)(WS_ZERO_BYTES / 16); i += Gn * NTHR) z[i] = zero; }
            LAS float* scr = (LAS float*)(lds + wave * 8448);
            for (int it = gw; it < 30720; it += NGW) {
                int r = it, idx, K_ = 1024, N_ = 1024, typ; const float* src;
                if (r < 2048) { idx = r >> 10; r &= 1023; src = INP(14) + (size_t)idx * 1024 * 2048; N_ = 2048; typ = 0; }
                else if ((r -= 2048) < 3072) { idx = r / 1536; r %= 1536; src = INP(15) + (size_t)idx * 1024 * 3072; N_ = 3072; typ = 1; }
                else if ((r -= 3072) < 1024) { idx = r >> 9; r &= 511; src = INP(17) + (size_t)idx * 1024 * 1024; typ = 2; }
                else if ((r -= 1024) < 2048) { idx = r >> 9; r &= 511; src = INP(18) + (size_t)idx * 1024 * 1024; typ = 3; }
                else if ((r -= 2048) < 4096) { idx = r >> 10; r &= 1023; src = INP(19) + (size_t)idx * 1024 * 2048; N_ = 2048; typ = 4; }
                else if ((r -= 4096) < 2048) { idx = r >> 9; r &= 511; src = INP(20) + (size_t)idx * 1024 * 1024; typ = 5; }
                else if ((r -= 2048) < 8192) { idx = r >> 11; r &= 2047; src = INP(21) + (size_t)idx * 1024 * 4096; N_ = 4096; typ = 6; }
                else { r -= 8192; idx = r >> 11; r &= 2047; src = INP(22) + (size_t)idx * 4096 * 1024; K_ = 4096; typ = 7; }
                const int nblk = N_ / 32, kb = r / nblk, nb = r % nblk, k0 = 64 * kb, n0 = 32 * nb; bf16_t* dst;
                switch (typ) {
                case 0: { const int n1 = n0 & 1023, row = (n1 >> 7) * 256 + (n0 >= 1024 ? 128 : 0) + (n1 & 127); dst = (bf16_t*)(ws + WS_WGLU) + ((size_t)idx * 2048 + row) * 1024; } break;
                case 1: { int row; if (n0 < 1024) row = n0; else { const int n1 = (n0 - 1024) & 1023; row = 1024 + (n1 >> 7) * 256 + (n0 >= 2048 ? 128 : 0) + (n1 & 127); } dst = (bf16_t*)(ws + WS_WIN) + ((size_t)idx * 3072 + row) * 1024; } break;
                case 2: dst = (bf16_t*)(ws + WS_WOUT) + ((size_t)idx * 1024 + n0) * 1024; break;
                case 3: dst = (bf16_t*)(ws + WS_WQ) + ((size_t)idx * 1024 + n0) * 1024; break;
                case 4: dst = (n0 < 1024) ? (bf16_t*)(ws + WS_WK) + ((size_t)idx * 1024 + n0) * 1024 : (bf16_t*)(ws + WS_WV) + ((size_t)idx * 1024 + n0 - 1024) * 1024; break;
                case 5: dst = (bf16_t*)(ws + WS_WO) + ((size_t)idx * 1024 + n0) * 1024; break;
                case 6: dst = (bf16_t*)(ws + WS_W1) + ((size_t)idx * 4096 + n0) * 1024; break;
                default: dst = (bf16_t*)(ws + WS_W2) + ((size_t)idx * 1024 + n0) * 4096; break;
                }
                transpose_item(src, K_, N_, dst, k0, n0, scr, lane);
            }
            for (int m = gw; m < BATCH * NMEM; m += NGW) { f32x4 v[4]; rms_row(INP(1) + (size_t)m * D, INP(2), lane, v); u32x2* o = (u32x2*)((bf16_t*)(ws + WS_MEMN) + (size_t)m * D) + lane;
#pragma unroll
                for (int jj = 0; jj < 4; ++jj) { u32x2 w; w.x = pk2(v[jj][0], v[jj][1]); w.y = pk2(v[jj][2], v[jj][3]); o[64 * jj] = w; } }
            __syncthreads();
            for (int ci = bx; ci < BATCH * NCH; ci += Gn) norm_chunk_to_uext(INP(0), INP(3), (bf16_t*)(big + BG_UEXT), ci, lds, wave, lane);
            { SsmIn si{INP(6), INP(7), INP(8), INP(9), INP(10), INP(11), INP(12), ws}; for (int g = bx; g < SG; g += Gn) build_ssm(si, 0, g, lds, tid); }
        } break;
        case PH_KVK: S.nM = BATCH * NMEM / 256; S.nN = 16; S.A = (const char*)(ws + WS_MEMN); S.B = (const char*)(ws + WS_WK); E.o0 = (bf16_t*)(ws + WS_KB); E.ldc = 4096; do_sync = false; break;
        case PH_KVV: S.nM = 16; S.nN = BATCH * NMEM / 256; S.A = (const char*)(ws + WS_WV); S.B = (const char*)(ws + WS_MEMN); E.o0 = (bf16_t*)(ws + WS_VT); E.ldc = 2048; S.c = (bx + Gn / 2) % Gn; do_sync = false; break;
        case PH_SSM1: S.nM = BATCH * SG; S.nN = 1; S.A = (const char*)(big + BG_UEXT); S.am = 256L * KX * 2; S.B = (const char*)(ws + WS_F); S.bn = 0; S.bg = 128L * 256 * 2; lda = KX; ldb = 256; K = 256;
            E.mode = pg8::M_G; E.f2 = (float*)(big + BG_G); local_seam = true; break;
        case PH_SCAN: is_gemm = false; local_seam = true; S.nM = BATCH * SG; S.nN = 1; S.nwg = S.nM; ssm_scan(ws, lds, S, wave, lane); break;
        case PH_SSM3: S.nM = BATCH * SG; S.nN = 1; S.A = (const char*)(big + BG_UEXT); S.am = 256L * KX * 2; S.B = (const char*)(ws + WS_W2X); S.bn = 0; S.bg = 256L * KX * 2; lda = KX; ldb = KX; K = KX;
            E.mode = pg8::M_Y; E.o0 = (bf16_t*)(big + BG_Y); E.b0 = (const bf16_t*)(big + BG_UEXT); E.f1 = INP(13) + (size_t)j * D; break;
        case PH_GLU: S.nN = 8; S.A = (const char*)(big + BG_Y); S.B = (const char*)(ws + WS_WGLU + (size_t)j * 2048 * 1024 * 2);
            E.mode = pg8::M_GLU; E.f0 = (l == 0) ? INP(0) : xres; E.f2 = xres; E.o0 = XG; E.f1 = INP(4) + (size_t)l * D; E.sout = SSb + (size_t)(l * 3 + 1) * T; break;
        case PH_Q: S.A = (const char*)XG; S.B = (const char*)(ws + WS_WQ + (size_t)l * 1024 * 1024 * 2);
            E.mode = pg8::M_SCALE; E.o0 = (bf16_t*)(big + BG_Q); E.sin = SSb + (size_t)(l * 3 + 1) * T; E.mul = 0.0625f * 1.4426950409f; local_seam = true; break;
        case PH_SP: S.A = (const char*)(big + BG_Q); S.an = 256 * 2; S.B = (const char*)(ws + WS_KB + (size_t)l * 1024 * 2); S.bn = 256 * 2; S.bb = 256L * 4096 * 2; ldb = 4096; K = 256;
            E.mode = pg8::M_P; E.o0 = (bf16_t*)(big + BG_P); E.sout = Lb; local_seam = true; break;
        case PH_OV: S.A = (const char*)(big + BG_P); S.an = 256 * 2; S.B = (const char*)(ws + WS_VT + (size_t)l * 1024 * 2048 * 2); S.bn = 256L * 2048 * 2; S.bb = 256 * 2; ldb = 2048; K = 256;
            E.mode = pg8::M_O; E.o0 = (bf16_t*)(big + BG_Q); E.sin = Lb; break;
        case PH_WO: S.A = (const char*)(big + BG_Q); S.B = (const char*)(ws + WS_WO + (size_t)l * 1024 * 1024 * 2);
            E.mode = pg8::M_RES; E.f0 = xres; E.f2 = xres; E.o0 = XG; E.f1 = INP(5) + (size_t)l * D; E.sout = SSb + (size_t)(l * 3 + 2) * T; break;
        case PH_UP: S.nN = 16; S.A = (const char*)XG; S.B = (const char*)(ws + WS_W1 + (size_t)l * 4096 * 1024 * 2);
            E.mode = pg8::M_UP; E.o0 = (bf16_t*)(big + BG_H); E.ldc = FF; E.sin = SSb + (size_t)(l * 3 + 2) * T; break;
        case PH_DOWN: S.A = (const char*)(big + BG_H); S.am = 256L * FF * 2; S.B = (const char*)(ws + WS_W2 + (size_t)l * 4096 * 1024 * 2); S.bn = 256L * FF * 2; lda = FF; ldb = FF; K = FF;
            E.mode = pg8::M_RES; E.f0 = xres; E.f2 = xres;
            if ((l & 1) == 0) { E.o0 = XG; E.f1 = INP(3) + (size_t)(l + 1) * D; E.sout = SSb + (size_t)((l + 1) * 3) * T; } break;
        case PH_CONVIN: S.nN = 12; S.A = (const char*)XG; S.B = (const char*)(ws + WS_WIN + (size_t)j * 3072 * 1024 * 2);
            E.mode = pg8::M_CONVIN; E.o0 = (bf16_t*)(big + BG_BC); E.o1 = (bf16_t*)(big + BG_Z); E.sin = SSb + (size_t)(l * 3) * T; break;
        case PH_CONV: { is_gemm = false;
            const bf16_t* Bc = (const bf16_t*)(big + BG_BC); const bf16_t* Z = (const bf16_t*)(big + BG_Z); bf16_t* Uc = (bf16_t*)(big + BG_UC); const float* cw = INP(16) + (size_t)j * 3 * D;
            for (int i = bx * NTHR + tid; i < T * 128; i += Gn * NTHR) { const int t = i >> 7, c8 = (i & 127) * 8, tl = t & (SEQ - 1); const size_t off = (size_t)t * D + c8;
                const u32x4 z0 = *(const u32x4*)(Z + off), bv = *(const u32x4*)(Bc + off); u32x4 z1 = {0u, 0u, 0u, 0u}, z2 = {0u, 0u, 0u, 0u};
                if (tl >= 1) z1 = *(const u32x4*)(Z + off - D); if (tl >= 2) z2 = *(const u32x4*)(Z + off - 2 * D);
                f32x4 o0, o1;
#pragma unroll
                for (int q = 0; q < 4; ++q) { const int cc = c8 + 2 * q;
                    const float w0a = cw[cc], w0b = cw[cc + 1], w1a = cw[D + cc], w1b = cw[D + cc + 1], w2a = cw[2 * D + cc], w2b = cw[2 * D + cc + 1];
                    const float ra = pg8::bf_lo(bv[q]) * (w0a * pg8::bf_lo(z2[q]) + w1a * pg8::bf_lo(z1[q]) + w2a * pg8::bf_lo(z0[q]));
                    const float rb = pg8::bf_hi(bv[q]) * (w0b * pg8::bf_hi(z2[q]) + w1b * pg8::bf_hi(z1[q]) + w2b * pg8::bf_hi(z0[q]));
                    if (q < 2) { o0[2 * q] = ra; o0[2 * q + 1] = rb; } else { o1[2 * (q - 2)] = ra; o1[2 * (q - 2) + 1] = rb; } }
                *(u32x4*)(Uc + off) = pg8::pack8(o0, o1); }
        } break;
        case PH_CONVOUT: S.A = (const char*)(big + BG_UC); S.B = (const char*)(ws + WS_WOUT + (size_t)j * 1024 * 1024 * 2);
            E.mode = pg8::M_RES; E.f0 = xres; E.f2 = xres; E.o0 = XG; E.f1 = INP(4) + (size_t)l * D; E.sout = SSb + (size_t)(l * 3 + 1) * T; break;
        case PH_NORM2: is_gemm = false;
            for (int ci = bx; ci < BATCH * NCH; ci += Gn) norm_chunk_to_uext(xres, INP(3) + 2 * D, (bf16_t*)(big + BG_UEXT), ci, lds, wave, lane);
            { SsmIn si{INP(6), INP(7), INP(8), INP(9), INP(10), INP(11), INP(12), ws}; for (int g = bx; g < SG; g += Gn) build_ssm(si, 1, g, lds, tid); }
            break;
        default: is_gemm = false;
            for (int m = gw; m < T; m += NGW) { f32x4 v[4]; rms_row(xres + (size_t)m * D, INP(23), lane, v); f32x4* o = (f32x4*)(xres + (size_t)m * D) + lane;
#pragma unroll
                for (int jj = 0; jj < 4; ++jj) o[64 * jj] = v[jj]; }
            do_sync = false; break;
        }
        S.nwg = S.nM * S.nN;
        if (is_gemm) { const int nrep = ((PROBE_REP_MASK >> ph) & 1u) ? 2 : 1;
#pragma nounroll
            for (int rp = 0; rp < nrep; ++rp) pg8::gemm_phase<pg8::Epi, pg8::Order, true, true>(lds, lda, ldb, K, S, E, tid); }
        if (do_sync) {
            if (local_seam) {
                asm volatile("s_waitcnt vmcnt(0)" ::: "memory"); __builtin_amdgcn_fence(__ATOMIC_ACQUIRE, "agent"); asm volatile("s_waitcnt vmcnt(0)" ::: "memory"); __syncthreads();
            } else if (pi == 0) {
                __builtin_amdgcn_fence(__ATOMIC_RELEASE, "agent"); asm volatile("s_waitcnt vmcnt(0)" ::: "memory");
#pragma nounroll
                for (int sr = 0; sr < PROBE_SYNC_REP; ++sr) grid.sync();
                __builtin_amdgcn_fence(__ATOMIC_ACQUIRE, "agent"); asm volatile("s_waitcnt vmcnt(0)" ::: "memory");
            } else {
#pragma nounroll
                for (int sr = 0; sr < PROBE_SYNC_REP; ++sr) { unsigned* barp = (unsigned*)(ws + WS_BAR); XcdBarrier xb; xb.bar = barp; xb.x = xb_xcc_id(); xb.st = (volatile LAS unsigned*)(lds + 131072 + 64); xcd_barrier(xb); }
            }
        }
    }
}

extern "C" void kernel_launch(void* const* d_in, const int* in_sizes, int n_in, void* d_out, int out_size, void* d_ws, size_t ws_size, hipStream_t stream) {
    static int grid = 0;
    if (grid == 0) {
        if (n_in != 24 || out_size != T * D || ws_size < WS_END) { fprintf(stderr, "kernel_launch: unexpected shapes (n_in %d out %d ws %zu)\n", n_in, out_size, ws_size); grid = -1; return; }
        int dev = 0, cus = 0, per_cu = 0;
        (void)hipGetDevice(&dev); (void)hipDeviceGetAttribute(&cus, hipDeviceAttributeMultiprocessorCount, dev);
        if (hipFuncSetAttribute((const void*)mega_fwd, hipFuncAttributeMaxDynamicSharedMemorySize, LDS_BYTES) != hipSuccess) { fprintf(stderr, "kernel_launch: hipFuncSetAttribute failed\n"); grid = -1; return; }
        if (hipOccupancyMaxActiveBlocksPerMultiprocessor(&per_cu, (const void*)mega_fwd, NTHR, LDS_BYTES) != hipSuccess || per_cu < 1) { (void)hipGetLastError(); per_cu = 1; }
        grid = cus * per_cu;
        fprintf(stderr, "kernel_launch: %d CUs x %d blocks/CU\n", cus, per_cu);
    }
    if (grid < 0) return;
    if (hipMemsetAsync((char*)d_ws + WS_BAR, 0, XCD_BAR_WORDS * 4, stream) != hipSuccess) { fprintf(stderr, "kernel_launch: memset failed\n"); return; }
    Args a{};
    for (int i = 0; i < 24; ++i) a.in[i] = (const float*)d_in[i];
    a.out = (float*)d_out; a.ws = (unsigned char*)d_ws;
    void* kargs[] = {&a};
    hipError_t e = hipLaunchCooperativeKernel((const void*)mega_fwd, dim3(grid), dim3(NTHR), kargs, LDS_BYTES, stream);
    if (e != hipSuccess) fprintf(stderr, "kernel_launch: cooperative launch failed: %s (grid %d)\n", hipGetErrorString(e), grid);
}
```

```cpp
#include <hip/hip_runtime.h>
#include <hip/hip_cooperative_groups.h>
#include <cstdio>
#include <cstdint>
namespace cg = cooperative_groups;

namespace pg8 {
#define PG8_LAS __attribute__((address_space(3)))
typedef unsigned short bf16_t;
typedef short bf16x8 __attribute__((ext_vector_type(8)));
typedef float f32x4 __attribute__((ext_vector_type(4)));
typedef unsigned u32x4 __attribute__((ext_vector_type(4)));
typedef unsigned u32x2 __attribute__((ext_vector_type(2)));
constexpr int BM = 256, BK = 64, HALF = 128, HTB = HALF * BK * 2  , STAGE_BYTES = 8 * HTB, NXCD = 8, WGM = 8;

__host__ __device__ __forceinline__ int lds_byte(int r, int c) { const int st = (r >> 4) * 2 + (c >> 5), rr = r & 15, cc = c & 31, ob = rr * 64 + cc * 2; return st * 1024 + (ob ^ (((ob >> 9) & 1) << 5)); }
__host__ __device__ __forceinline__ void stage_rc(int b, int& R, int& C) { const int st = b / 1024, sb = b % 1024, swz = sb ^ (((sb >> 9) & 1) << 5); R = (st >> 1) * 16 + swz / 64; C = (st & 1) * 32 + (swz % 64) / 2; }
__host__ __device__ __forceinline__ int perm32(int rho) { const int n = rho >> 4, i = rho & 15; return 8 * (i >> 2) + 4 * n + (i & 3); }

struct Unit { int pm, pn; };

struct Order {
    int nM, nN, nwg, G, c; const char* A; const char* B; long am, an, bn, bb, bg;
    __device__ __forceinline__ bool next(int i, Unit& u) const {
        const long L = (long)i * G + c; if (L >= nwg) return false;
        int wgid = (int)L; { const int q = nwg / NXCD, r = nwg % NXCD, xcd = wgid % NXCD, off = wgid / NXCD; wgid = (xcd < r ? xcd * (q + 1) : r * (q + 1) + (xcd - r) * q) + off; }
        const int nig = WGM * nN, gid = wgid / nig, fm = gid * WGM, gsz = (nM - fm) < WGM ? (nM - fm) : WGM;
        u.pm = fm + ((wgid % nig) % gsz); u.pn = (wgid % nig) / gsz; return true;
    }
    __device__ __forceinline__ const char* abase(const Unit& u) const { return A + (long)u.pm * am + (long)u.pn * an; }
    __device__ __forceinline__ const char* bbase(const Unit& u) const { return B + (long)u.pn * bn + (long)(u.pm >> 4) * bb + (long)(u.pm & 63) * bg; }
};

__device__ __forceinline__ unsigned cvt_pk_bf16(float lo, float hi) { unsigned r; asm volatile("v_cvt_pk_bf16_f32 %0, %1, %2" : "=v"(r) : "v"(lo), "v"(hi)); return r; }
__device__ __forceinline__ u32x4 pack8(const f32x4 a, const f32x4 b) { u32x4 w; w.x = cvt_pk_bf16(a[0], a[1]); w.y = cvt_pk_bf16(a[2], a[3]); w.z = cvt_pk_bf16(b[0], b[1]); w.w = cvt_pk_bf16(b[2], b[3]); return w; }
__device__ __forceinline__ float bf_lo(unsigned w) { return __uint_as_float(w << 16); }
__device__ __forceinline__ float bf_hi(unsigned w) { return __uint_as_float(w & 0xffff0000u); }

enum { M_STORE = 0, M_SCALE, M_UP, M_CONVIN, M_RES, M_GLU, M_P, M_O, M_G, M_Y };
__device__ __forceinline__ float gelu_tanh(float y) {
    const float z = 0.7978845608f * (y + 0.044715f * y * y * y);
    const float e = __builtin_amdgcn_exp2f(z * 2.8853900818f);
    const float t = 1.0f - 2.0f * __builtin_amdgcn_rcpf(1.0f + e);
    return 0.5f * y * (1.0f + t);
}
struct Epi {
    static constexpr bool PERM = true;
    int mode, ldc; float mul;
    bf16_t* o0; bf16_t* o1; const float* f0; const float* f1; float* f2; const bf16_t* b0;
    const unsigned long long* sin; unsigned long long* sout;
    __device__ __forceinline__ void operator()(const f32x4 (&acc)[2][2][4][2], const Unit& u, int wr, int wc, int fr, int fq) const {
        const int r0 = u.pm * 256 + wr * 64 + fr;
        const int cw = wc * 32 + 8 * fq;
        if (mode == M_STORE || mode == M_SCALE || mode == M_UP) {
#pragma unroll
            for (int ai = 0; ai < 2; ++ai)
#pragma unroll
                for (int m = 0; m < 4; ++m) { const int row = r0 + ai * 128 + m * 16; float rs = 1.0f;
                    if (mode != M_STORE) rs = __builtin_amdgcn_rsqf((float)sin[row] * (1.0f / (1024.0f * 1048576.0f)) + 1e-6f) * mul;
                    bf16_t* rowp = o0 + (size_t)row * ldc + u.pn * 256 + cw;
#pragma unroll
                    for (int bj = 0; bj < 2; ++bj) { f32x4 v0 = acc[ai][bj][m][0] * rs, v1 = acc[ai][bj][m][1] * rs;
                        if (mode == M_UP) {
#pragma unroll
                            for (int j = 0; j < 4; ++j) { const float a = fmaxf(v0[j], 0.f), b = fmaxf(v1[j], 0.f); v0[j] = a * a; v1[j] = b * b; } }
                        *(u32x4*)(rowp + bj * 128) = pack8(v0, v1); } }
        } else if (mode == M_CONVIN) {
#pragma unroll
            for (int ai = 0; ai < 2; ++ai)
#pragma unroll
                for (int m = 0; m < 4; ++m) { const int row = r0 + ai * 128 + m * 16;
                    const float rs = __builtin_amdgcn_rsqf((float)sin[row] * (1.0f / (1024.0f * 1048576.0f)) + 1e-6f);
                    if (u.pn < 4) { bf16_t* rowp = o0 + (size_t)row * 1024 + u.pn * 256 + cw;
#pragma unroll
                        for (int bj = 0; bj < 2; ++bj) *(u32x4*)(rowp + bj * 128) = pack8(acc[ai][bj][m][0] * rs, acc[ai][bj][m][1] * rs);
                    } else { bf16_t* rowp = o1 + (size_t)row * 1024 + (u.pn - 4) * 128 + cw; const float r2 = rs * rs;
                        *(u32x4*)rowp = pack8(acc[ai][0][m][0] * acc[ai][1][m][0] * r2, acc[ai][0][m][1] * acc[ai][1][m][1] * r2); } }
        } else if (mode == M_RES) {
#pragma unroll
            for (int ai = 0; ai < 2; ++ai)
#pragma unroll
                for (int m = 0; m < 4; ++m) { const int row = r0 + ai * 128 + m * 16; bf16_t* xp = o0 + (size_t)row * 1024 + u.pn * 256 + cw; float ssq = 0.f;
#pragma unroll
                    for (int bj = 0; bj < 2; ++bj) { const u32x4 xw = *(const u32x4*)(xp + bj * 128);
                        f32x4 v0 = acc[ai][bj][m][0], v1 = acc[ai][bj][m][1];
                        v0[0] += bf_lo(xw.x); v0[1] += bf_hi(xw.x); v0[2] += bf_lo(xw.y); v0[3] += bf_hi(xw.y); v1[0] += bf_lo(xw.z); v1[1] += bf_hi(xw.z); v1[2] += bf_lo(xw.w); v1[3] += bf_hi(xw.w);
                        ssq += (v0[0] * v0[0] + v0[1] * v0[1]) + (v0[2] * v0[2] + v0[3] * v0[3]) + (v1[0] * v1[0] + v1[1] * v1[1]) + (v1[2] * v1[2] + v1[3] * v1[3]);
                        *(u32x4*)(xp + bj * 128) = pack8(v0, v1); }
                    if (sout) { ssq += __shfl_xor(ssq, 16); ssq += __shfl_xor(ssq, 32); if (fq == 0) atomicAdd(sout + row, (unsigned long long)(ssq * 1048576.0f + 0.5f)); } }
        } else if (mode == M_GLU) {
#pragma unroll
            for (int ai = 0; ai < 2; ++ai)
#pragma unroll
                for (int m = 0; m < 4; ++m) { const int row = r0 + ai * 128 + m * 16; const size_t off = (size_t)row * 1024 + u.pn * 128 + cw;
                    f32x4 v[2]; float ssq = 0.f;
                    if (f0) { v[0] = *(const f32x4*)(f0 + off); v[1] = *(const f32x4*)(f0 + off + 4); }
                    else { const u32x4 xw = *(const u32x4*)(o0 + off); v[0] = (f32x4){bf_lo(xw.x), bf_hi(xw.x), bf_lo(xw.y), bf_hi(xw.y)}; v[1] = (f32x4){bf_lo(xw.z), bf_hi(xw.z), bf_lo(xw.w), bf_hi(xw.w)}; }
#pragma unroll
                    for (int n = 0; n < 2; ++n) { const f32x4 val = acc[ai][0][m][n], gate = acc[ai][1][m][n];
#pragma unroll
                        for (int j = 0; j < 4; ++j) { const float sg = __builtin_amdgcn_rcpf(1.0f + __builtin_amdgcn_exp2f(-1.4426950409f * gate[j])); v[n][j] += val[j] * sg; ssq += v[n][j] * v[n][j]; } }
                    *(u32x4*)(o0 + off) = pack8(v[0], v[1]);
                    ssq += __shfl_xor(ssq, 16); ssq += __shfl_xor(ssq, 32); if (fq == 0) atomicAdd(sout + row, (unsigned long long)(ssq * 1048576.0f + 0.5f)); }
        } else if (mode == M_P) {
#pragma unroll
            for (int ai = 0; ai < 2; ++ai)
#pragma unroll
                for (int m = 0; m < 4; ++m) { const int row = r0 + ai * 128 + m * 16; bf16_t* rowp = o0 + (size_t)row * 1024 + u.pn * 256 + cw; float s = 0.f;
#pragma unroll
                    for (int bj = 0; bj < 2; ++bj) { f32x4 v0, v1;
#pragma unroll
                        for (int j = 0; j < 4; ++j) { v0[j] = __builtin_amdgcn_exp2f(acc[ai][bj][m][0][j]); v1[j] = __builtin_amdgcn_exp2f(acc[ai][bj][m][1][j]); s += v0[j] + v1[j]; }
                        *(u32x4*)(rowp + bj * 128) = pack8(v0, v1); }
                    s += __shfl_xor(s, 16); s += __shfl_xor(s, 32); if (fq == 0) atomicAdd(sout + (size_t)row * 4 + u.pn, (unsigned long long)(s * 65536.0f + 0.5f)); }
        } else if (mode == M_O) {
#pragma unroll
            for (int ai = 0; ai < 2; ++ai)
#pragma unroll
                for (int m = 0; m < 4; ++m) { const int row = r0 + ai * 128 + m * 16; const float inv = 65536.0f / (float)sin[(size_t)row * 4 + u.pn];
                    bf16_t* rowp = o0 + (size_t)row * 1024 + u.pn * 256 + cw;
#pragma unroll
                    for (int bj = 0; bj < 2; ++bj) *(u32x4*)(rowp + bj * 128) = pack8(acc[ai][bj][m][0] * inv, acc[ai][bj][m][1] * inv); }
        } else if (mode == M_G) {
#pragma unroll
            for (int ai = 0; ai < 2; ++ai)
#pragma unroll
                for (int m = 0; m < 4; ++m) { float* p = f2 + (size_t)(r0 + ai * 128 + m * 16) * 128 + cw;
                    *(f32x4*)p = acc[ai][0][m][0]; *(f32x4*)(p + 4) = acc[ai][0][m][1]; }
        } else {
            const int b = u.pm >> 6, g = u.pm & 63, ho0 = (fq & 1) * 8;
            const f32x4 d0 = *(const f32x4*)(f1 + g * 16 + ho0), d1 = *(const f32x4*)(f1 + g * 16 + ho0 + 4);
#pragma unroll
            for (int ai = 0; ai < 2; ++ai)
#pragma unroll
                for (int m = 0; m < 4; ++m) { const int c = ai * 128 + wr * 64 + m * 16 + fr;
#pragma unroll
                    for (int bj = 0; bj < 2; ++bj) { const int jt = bj * 8 + wc * 2 + (fq >> 1);
                        const u32x4 uw = *(const u32x4*)(b0 + ((size_t)u.pm * 256 + c) * 384 + jt * 16 + ho0);
                        f32x4 v0 = acc[ai][bj][m][0], v1 = acc[ai][bj][m][1];
                        v0[0] += d0[0] * bf_lo(uw.x); v0[1] += d0[1] * bf_hi(uw.x); v0[2] += d0[2] * bf_lo(uw.y); v0[3] += d0[3] * bf_hi(uw.y);
                        v1[0] += d1[0] * bf_lo(uw.z); v1[1] += d1[1] * bf_hi(uw.z); v1[2] += d1[2] * bf_lo(uw.w); v1[3] += d1[3] * bf_hi(uw.w);
#pragma unroll
                        for (int j = 0; j < 4; ++j) { v0[j] = gelu_tanh(v0[j]); v1[j] = gelu_tanh(v1[j]); }
                        *(u32x4*)(o0 + ((size_t)b * 4096 + c * 16 + jt) * 1024 + g * 16 + ho0) = pack8(v0, v1); } }
        }
    }
};

template <class Epi, class Sched, bool ALIGN_EPI = false, bool SP2 = false>
__device__ __forceinline__ void gemm_phase(PG8_LAS unsigned char* lds, const int lda, const int ldb, const int K, const Sched& S, const Epi& E, const int tid) {
    const int wid = __builtin_amdgcn_readfirstlane(tid >> 6), lane = tid & 63, wr = wid >> 2, wc = wid & 3, fr = lane & 15, fq = lane >> 4;
    const int nt = K / BK;
    unsigned voffA[2], voffB[2];
#pragma unroll
    for (int i = 0; i < 2; ++i) { int R, C; stage_rc(tid * 16 + i * 8192, R, C); const int Rb = Epi::PERM ? ((R & ~31) + perm32(R & 31)) : R;
        voffA[i] = (unsigned)(R * lda + C) * 2u; voffB[i] = (unsigned)(Rb * ldb + C) * 2u; }
    const size_t kstep = (size_t)(BK * 2);
    const size_t hstepA = (size_t)HALF * lda * 2, hstepB = (size_t)HALF * ldb * 2;
    const unsigned ldsw = (unsigned)wid * 1024u;
    const int aoff = lds_byte(wr * 64 + fr, fq * 8), boff = lds_byte(wc * 32 + fr, fq * 8);
#define PG8_SA(b, h) (((b) * 2 + (h)) * HTB)
#define PG8_SB(b, h) ((4 + (b) * 2 + (h)) * HTB)
#define PG8_STAGE(bufoff, gbase, voff) do { _Pragma("unroll") for (int _i = 0; _i < 2; ++_i) \
        __builtin_amdgcn_global_load_lds((const unsigned*)((const char*)(gbase) + (voff)[_i]), (PG8_LAS unsigned*)(lds + (bufoff) + ldsw + _i * 8192), 16, 0, 0); } while (0)
#define PG8_LDA(dst, b, h) do { _Pragma("unroll") for (int m = 0; m < 4; ++m) _Pragma("unroll") for (int k = 0; k < 2; ++k) dst[m][k] = *(const PG8_LAS bf16x8*)(lds + PG8_SA(b, h) + aoff + m * 2048 + k * 1024); } while (0)
#define PG8_LDB(dst, b, h) do { _Pragma("unroll") for (int n = 0; n < 2; ++n) _Pragma("unroll") for (int k = 0; k < 2; ++k) dst[n][k] = *(const PG8_LAS bf16x8*)(lds + PG8_SB(b, h) + boff + n * 2048 + k * 1024); } while (0)
#define PG8_MMA(ai, bj, At, Bt) do { __builtin_amdgcn_s_setprio(1); _Pragma("unroll") for (int m = 0; m < 4; ++m) _Pragma("unroll") for (int n = 0; n < 2; ++n) _Pragma("unroll") for (int k = 0; k < 2; ++k) \
        acc[ai][bj][m][n] = __builtin_amdgcn_mfma_f32_16x16x32_bf16(Bt[n][k], At[m][k], acc[ai][bj][m][n], 0, 0, 0); __builtin_amdgcn_s_setprio(0); } while (0)
#define PG8_WAIT_V(n) asm volatile("s_waitcnt vmcnt(" #n ")" ::: "memory")
#define PG8_WAIT_L(n) asm volatile("s_waitcnt lgkmcnt(" #n ")" ::: "memory")
#define PG8_BAR __builtin_amdgcn_s_barrier()
#define PG8_SCHED __builtin_amdgcn_sched_barrier(0)
    Unit cur, nxt; int ui = 0;
    if (!S.next(0, cur)) return;
    f32x4 acc[2][2][4][2];
#pragma unroll
    for (int a = 0; a < 2; ++a)
#pragma unroll
        for (int b = 0; b < 2; ++b)
#pragma unroll
            for (int m = 0; m < 4; ++m)
#pragma unroll
                for (int n = 0; n < 2; ++n) acc[a][b][m][n] = (f32x4){0.f, 0.f, 0.f, 0.f};
    bf16x8 At[4][2], B0[2][2], B1[2][2];
    const char* cA = S.abase(cur); const char* cB = S.bbase(cur);
    if constexpr (SP2) {
        PG8_STAGE(PG8_SB(0, 0), cB, voffB); PG8_STAGE(PG8_SB(0, 1), cB + hstepB, voffB); PG8_STAGE(PG8_SA(0, 0), cA, voffA); PG8_STAGE(PG8_SA(0, 1), cA + hstepA, voffA);
        if (wr == 1) PG8_BAR;
        PG8_WAIT_V(2); PG8_BAR;
        PG8_STAGE(PG8_SB(1, 0), cB + kstep, voffB); PG8_STAGE(PG8_SA(1, 0), cA + kstep, voffA); PG8_STAGE(PG8_SB(1, 1), cB + hstepB + kstep, voffB);
        PG8_WAIT_V(6); PG8_BAR;
    } else {
        PG8_STAGE(PG8_SB(0, 0), cB, voffB); PG8_STAGE(PG8_SA(0, 0), cA, voffA); PG8_STAGE(PG8_SB(0, 1), cB + hstepB, voffB); PG8_STAGE(PG8_SA(0, 1), cA + hstepA, voffA);
        if (wr == 1) PG8_BAR;
        PG8_WAIT_V(4); PG8_BAR;
        PG8_STAGE(PG8_SB(1, 0), cB + kstep, voffB); PG8_STAGE(PG8_SA(1, 0), cA + kstep, voffA); PG8_STAGE(PG8_SB(1, 1), cB + hstepB + kstep, voffB);
        PG8_WAIT_V(6); PG8_BAR;
    }
    for (;;) {
        const bool has_next = S.next(ui + 1, nxt);
        const char* nA = has_next ? S.abase(nxt) : cA; const char* nB = has_next ? S.bbase(nxt) : cB;
        for (int t = 0; t < nt; t += 2) {
            const bool last = (t == nt - 2);
            const char* a1 = cA + (size_t)(t + 1) * kstep;
            const char* a2 = last ? nA : cA + (size_t)(t + 2) * kstep; const char* b2 = last ? nB : cB + (size_t)(t + 2) * kstep;
            const char* a3 = a2 + kstep; const char* b3 = b2 + kstep;
            if constexpr (SP2) {
            PG8_LDB(B0, 0, 0); PG8_LDB(B1, 0, 1); PG8_SCHED; PG8_LDA(At, 0, 0); PG8_STAGE(PG8_SA(1, 1), a1 + hstepA, voffA);
            PG8_WAIT_V(8); PG8_WAIT_L(0); PG8_BAR; PG8_MMA(0, 0, At, B0); PG8_MMA(0, 1, At, B1); PG8_BAR; PG8_SCHED;
            PG8_LDA(At, 0, 1); PG8_STAGE(PG8_SB(0, 0), b2, voffB); PG8_STAGE(PG8_SB(0, 1), b2 + hstepB, voffB); PG8_STAGE(PG8_SA(0, 0), a2, voffA);
            PG8_WAIT_V(8); PG8_WAIT_L(0); PG8_BAR; PG8_MMA(1, 0, At, B0); PG8_MMA(1, 1, At, B1); PG8_BAR; PG8_SCHED;
            PG8_LDB(B0, 1, 0); PG8_LDB(B1, 1, 1); PG8_SCHED; PG8_LDA(At, 1, 0); PG8_STAGE(PG8_SA(0, 1), a2 + hstepA, voffA);
            PG8_WAIT_V(8); PG8_WAIT_L(0); PG8_BAR; PG8_MMA(0, 0, At, B0); PG8_MMA(0, 1, At, B1); PG8_BAR; PG8_SCHED;
            PG8_LDA(At, 1, 1); PG8_STAGE(PG8_SB(1, 0), b3, voffB); PG8_STAGE(PG8_SB(1, 1), b3 + hstepB, voffB); PG8_STAGE(PG8_SA(1, 0), a3, voffA);
            PG8_WAIT_V(8); PG8_WAIT_L(0); PG8_BAR; PG8_MMA(1, 0, At, B0); PG8_MMA(1, 1, At, B1); PG8_BAR; PG8_SCHED;
            } else {
            PG8_LDB(B0, 0, 0); PG8_SCHED; PG8_LDA(At, 0, 0); PG8_STAGE(PG8_SA(1, 1), a1 + hstepA, voffA);
            PG8_WAIT_L(8); PG8_BAR; PG8_WAIT_L(0); PG8_MMA(0, 0, At, B0); PG8_BAR; PG8_SCHED;
            PG8_LDB(B1, 0, 1); PG8_STAGE(PG8_SB(0, 0), b2, voffB);
            PG8_BAR; PG8_WAIT_L(0); PG8_MMA(0, 1, At, B1); PG8_BAR;
            PG8_LDA(At, 0, 1); PG8_STAGE(PG8_SA(0, 0), a2, voffA);
            PG8_BAR; PG8_WAIT_L(0); PG8_MMA(1, 0, At, B0); PG8_BAR; PG8_SCHED;
            PG8_STAGE(PG8_SB(0, 1), b2 + hstepB, voffB);
            PG8_WAIT_V(6); PG8_BAR; PG8_MMA(1, 1, At, B1); PG8_BAR;
            PG8_LDB(B0, 1, 0); PG8_SCHED; PG8_LDA(At, 1, 0); PG8_STAGE(PG8_SA(0, 1), a2 + hstepA, voffA);
            PG8_WAIT_L(8); PG8_BAR; PG8_WAIT_L(0); PG8_MMA(0, 0, At, B0); PG8_BAR; PG8_SCHED;
            PG8_LDB(B1, 1, 1); PG8_STAGE(PG8_SB(1, 0), b3, voffB);
            PG8_BAR; PG8_WAIT_L(0); PG8_MMA(0, 1, At, B1); PG8_BAR;
            PG8_LDA(At, 1, 1); PG8_STAGE(PG8_SA(1, 0), a3, voffA);
            PG8_BAR; PG8_WAIT_L(0); PG8_MMA(1, 0, At, B0); PG8_BAR; PG8_SCHED;
            PG8_STAGE(PG8_SB(1, 1), b3 + hstepB, voffB);
            PG8_WAIT_V(6); PG8_BAR; PG8_MMA(1, 1, At, B1); PG8_BAR;
            }
        }
        if constexpr (ALIGN_EPI) { if (wr == 0) PG8_BAR; }
        { int frv = fr, fqv = fq; asm volatile("" : "+v"(frv), "+v"(fqv)); E(acc, cur, wr, wc, frv, fqv); }
        if (!has_next) break;
#pragma unroll
        for (int a = 0; a < 2; ++a)
#pragma unroll
            for (int b = 0; b < 2; ++b)
#pragma unroll
                for (int m = 0; m < 4; ++m)
#pragma unroll
                    for (int n = 0; n < 2; ++n) acc[a][b][m][n] = (f32x4){0.f, 0.f, 0.f, 0.f};
        cur = nxt; cA = nA; cB = nB; ++ui;
        if constexpr (ALIGN_EPI) { if (wr == 1) PG8_BAR; }
    }
    PG8_WAIT_V(0);
    if constexpr (!ALIGN_EPI) { if (wr == 0) PG8_BAR; }
    PG8_BAR;
#undef PG8_SA
#undef PG8_SB
#undef PG8_STAGE
#undef PG8_LDA
#undef PG8_LDB
#undef PG8_MMA
#undef PG8_WAIT_V
#undef PG8_WAIT_L
#undef PG8_BAR
#undef PG8_SCHED
}
}
using pg8::bf16_t; using pg8::f32x4; using pg8::u32x4; using pg8::u32x2;
#define LAS __attribute__((address_space(3)))

constexpr int BATCH = 8, SEQ = 4096, D = 1024, T = BATCH * SEQ, DEPTH = 4, NMEM = 256, HEADS = 4, HD = 256, FF = 4096;
constexpr int SG = 64, SP = 64, SH = 16, CL = 16, NCH = SEQ / CL;
constexpr int KX = CL * SH + 2 * SP;
constexpr float EPS = 1e-6f;
constexpr int NWAVES = 8, NTHR = 512;
constexpr int LDS_BYTES = 147456;

constexpr size_t MiB = 1u << 20;
constexpr size_t WS_SS = 0;
constexpr size_t WS_L = 4 * MiB;
constexpr size_t WS_ZERO_BYTES = 8 * MiB;
constexpr size_t WS_TAB = 8 * MiB;
constexpr size_t WS_F = 9 * MiB;
constexpr size_t WS_W2X = 14 * MiB;
constexpr size_t WS_MEMN = 26 * MiB;
constexpr size_t WS_KB = 30 * MiB;
constexpr size_t WS_VT = 46 * MiB;
constexpr size_t WS_WGLU = 62 * MiB, WS_WIN = 70 * MiB, WS_WOUT = 82 * MiB, WS_WQ = 86 * MiB, WS_WK = 94 * MiB, WS_WV = 102 * MiB, WS_WO = 110 * MiB, WS_W1 = 118 * MiB, WS_W2 = 150 * MiB;
constexpr size_t WS_XG = 182 * MiB;
constexpr size_t WS_BIG = 246 * MiB;
constexpr size_t WS_BAR = 502 * MiB;
constexpr size_t WS_END = 503 * MiB;
constexpr size_t BG_H = 0, BG_Q = 0, BG_P = 64 * MiB, BG_BC = 0, BG_Z = 64 * MiB, BG_UC = 128 * MiB, BG_UEXT = 0, BG_G = 96 * MiB, BG_Y = 160 * MiB;

struct Args { const float* in[24]; float* out; unsigned char* ws; };

__device__ __forceinline__ float wave_sum(float v) {
#pragma unroll
    for (int o = 1; o < 64; o <<= 1) v += __shfl_xor(v, o);
    return v;
}
__device__ __forceinline__ unsigned f2bf(float f) { unsigned u = __float_as_uint(f); return (u + 0x7fffu + ((u >> 16) & 1u)) >> 16; }
__device__ __forceinline__ unsigned pk2(float lo, float hi) { return f2bf(lo) | (f2bf(hi) << 16); }

__device__ __forceinline__ void transpose_item(const float* W, int K, int N, bf16_t* drow0, int k0, int n0, const float* gain, LAS float* scr, int lane) {
    const float gl = gain ? gain[k0 + lane] : 1.0f;
    float wv[32];
    const float* wp = W + (size_t)(k0 + (lane >> 5)) * N + n0 + (lane & 31);
#pragma unroll
    for (int i = 0; i < 32; ++i) wv[i] = __builtin_nontemporal_load(wp + (size_t)(2 * i) * N);
    asm volatile("" ::: "memory");
#pragma unroll
    for (int i = 0; i < 32; ++i) { const int kk = 2 * i + (lane >> 5); scr[kk * 33 + (lane & 31)] = wv[i] * __shfl(gl, kk); }
    asm volatile("s_waitcnt lgkmcnt(0)" ::: "memory");
    const int c = lane & 7;
#pragma unroll
    for (int j = 0; j < 4; ++j) { const int n = (lane >> 3) + 8 * j; const LAS float* s = scr + (8 * c) * 33 + n;
        u32x4 o; o.x = pk2(s[0 * 33], s[1 * 33]); o.y = pk2(s[2 * 33], s[3 * 33]); o.z = pk2(s[4 * 33], s[5 * 33]); o.w = pk2(s[6 * 33], s[7 * 33]);
        *(u32x4*)(drow0 + (size_t)n * K + k0 + 8 * c) = o; }
    asm volatile("s_waitcnt lgkmcnt(0)" ::: "memory");
}

__device__ __forceinline__ void rms_row(const float* xrow, const float* gain, int lane, f32x4 (&v)[4]) {
    const f32x4* xr = (const f32x4*)xrow + lane; const f32x4* gr = (const f32x4*)gain + lane; float s = 0.f;
#pragma unroll
    for (int j = 0; j < 4; ++j) { v[j] = xr[64 * j]; s += (v[j][0] * v[j][0] + v[j][1] * v[j][1]) + (v[j][2] * v[j][2] + v[j][3] * v[j][3]); }
    const float rstd = 1.0f / sqrtf(wave_sum(s) * (1.0f / D) + EPS);
#pragma unroll
    for (int j = 0; j < 4; ++j) v[j] = v[j] * rstd * gr[64 * j];
}

__device__ __forceinline__ void rms_row_bf(const bf16_t* xrow, const float* gain, int lane, f32x4 (&v)[4]) {
    const u32x2* xr = (const u32x2*)xrow + lane; const f32x4* gr = (const f32x4*)gain + lane; float s = 0.f;
#pragma unroll
    for (int j = 0; j < 4; ++j) { const u32x2 w = xr[64 * j]; v[j] = (f32x4){pg8::bf_lo(w.x), pg8::bf_hi(w.x), pg8::bf_lo(w.y), pg8::bf_hi(w.y)}; s += (v[j][0] * v[j][0] + v[j][1] * v[j][1]) + (v[j][2] * v[j][2] + v[j][3] * v[j][3]); }
    const float rstd = 1.0f / sqrtf(wave_sum(s) * (1.0f / D) + EPS);
#pragma unroll
    for (int j = 0; j < 4; ++j) v[j] = v[j] * rstd * gr[64 * j];
}

template <bool BF> __device__ __forceinline__ void norm_chunk_to_uext(const void* x, const float* gain, bf16_t* uext, int ci, LAS unsigned char* lds, int wave, int lane) {
    const int b = ci >> 8, c = ci & 255; const size_t t0 = (size_t)b * SEQ + c * CL;
    constexpr int PITCH = 2064;
    f32x4 vv[2][4];
#pragma unroll
    for (int r = 0; r < 2; ++r) { const int tok = r * 8 + wave;
        if (BF) { const u32x2* xr = (const u32x2*)((const bf16_t*)x + (t0 + tok) * D) + lane;
#pragma unroll
            for (int j = 0; j < 4; ++j) { const u32x2 w = xr[64 * j]; vv[r][j] = (f32x4){pg8::bf_lo(w.x), pg8::bf_hi(w.x), pg8::bf_lo(w.y), pg8::bf_hi(w.y)}; } }
        else { const f32x4* xr = (const f32x4*)((const float*)x + (t0 + tok) * D) + lane;
#pragma unroll
            for (int j = 0; j < 4; ++j) vv[r][j] = xr[64 * j]; } }
#pragma unroll
    for (int r = 0; r < 2; ++r) { const int tok = r * 8 + wave; float ss = 0.f; const f32x4* gr = (const f32x4*)gain + lane;
#pragma unroll
        for (int j = 0; j < 4; ++j) ss += (vv[r][j][0] * vv[r][j][0] + vv[r][j][1] * vv[r][j][1]) + (vv[r][j][2] * vv[r][j][2] + vv[r][j][3] * vv[r][j][3]);
        const float rstd = 1.0f / sqrtf(wave_sum(ss) * (1.0f / D) + EPS);
#pragma unroll
        for (int j = 0; j < 4; ++j) { const f32x4 v = vv[r][j] * rstd * gr[64 * j]; u32x2 w; w.x = pk2(v[0], v[1]); w.y = pk2(v[2], v[3]); *(LAS u32x2*)(lds + tok * PITCH + (4 * lane + 256 * j) * 2) = w; } }
    __syncthreads();
    const int l32 = lane & 31, tk = l32 >> 1, half = l32 & 1;
#pragma unroll
    for (int gi = 0; gi < 8; gi += 2) { const int g = wave * 8 + gi + (lane >> 5);
        const u32x4 w = *(const LAS u32x4*)(lds + tk * PITCH + (g * 16 + half * 8) * 2);
        *(u32x4*)(uext + ((size_t)(b * 64 + g) * 256 + c) * KX + tk * 16 + half * 8) = w; }
    __syncthreads();
}

struct SsmIn { const float *a_re, *a_im, *log_dt, *b_re, *b_im, *c_re, *c_im; unsigned char* ws; };
__device__ __forceinline__ void build_ssm(const SsmIn& a, int j, int g, LAS unsigned char* lds, int tid) {
    typedef float f32x2 __attribute__((ext_vector_type(2)));
    LAS f32x2* pw = (LAS f32x2*)lds;
    LAS f32x2* bb = (LAS f32x2*)(lds + 8704);
    LAS f32x2* cc = (LAS f32x2*)(lds + 16896);
    LAS float* kk = (LAS float*)(lds + 25088);
    const float* a_re = a.a_re + (size_t)(j * SG + g) * SP; const float* a_im = a.a_im + (size_t)(j * SG + g) * SP;
    const float dt = expf(a.log_dt[j * SG + g]);
    const float* b_re = a.b_re + (size_t)(j * SG + g) * SP * SH; const float* b_im = a.b_im + (size_t)(j * SG + g) * SP * SH;
    const float* c_re = a.c_re + (size_t)(j * SG + g) * SH * SP; const float* c_im = a.c_im + (size_t)(j * SG + g) * SH * SP;
    if (tid < 64) { const float are = a_re[tid], aim = a_im[tid];
        for (int k = 0; k <= 16; ++k) { const float mag = expf(are * dt * (float)k); double ang = (double)aim * (double)dt * (double)k; ang -= 6.283185307179586 * rint(ang * 0.15915494309189535);
            float sn, cs; sincosf((float)ang, &sn, &cs); pw[k * 64 + tid] = (f32x2){mag * cs, mag * sn}; }
        const float mag = expf(are * dt * 1024.0f); double ang = (double)aim * (double)dt * 1024.0; ang -= 6.283185307179586 * rint(ang * 0.15915494309189535);
        float sn, cs; sincosf((float)ang, &sn, &cs);
        f32x4 t; t[0] = pw[16 * 64 + tid].x; t[1] = pw[16 * 64 + tid].y; t[2] = mag * cs; t[3] = mag * sn;
        *(f32x4*)(a.ws + WS_TAB + ((size_t)g * 64 + tid) * 16) = t; }
    __syncthreads();
    for (int idx = tid; idx < 1024; idx += NTHR) { const int p = idx >> 4;
        const float are = a_re[p], aim = a_im[p]; const f32x2 ab = pw[64 + p];
        const float nr = ab.x - 1.0f, ni = ab.y, den = 1.0f / (are * are + aim * aim);
        const float qr = (nr * are + ni * aim) * den, qi = (ni * are - nr * aim) * den;
        const float br = b_re[idx], bi = b_im[idx];
        bb[idx] = (f32x2){qr * br - qi * bi, qr * bi + qi * br};
        cc[idx] = (f32x2){c_re[idx], c_im[idx]}; }
    __syncthreads();
    for (int idx = tid; idx < 4096; idx += NTHR) { const int k = idx >> 8, ho = (idx >> 4) & 15, hi = idx & 15; float s = 0.f;
        for (int p = 0; p < 64; ++p) { const f32x2 c = cc[ho * 64 + p], w = pw[k * 64 + p], bq = bb[p * 16 + hi];
            const float tr = c.x * w.x - c.y * w.y, ti = c.x * w.y + c.y * w.x; s += tr * bq.x - ti * bq.y; }
        kk[idx] = s; }
    __syncthreads();
    unsigned* w2 = (unsigned*)(a.ws + WS_W2X) + (size_t)g * 256 * (KX / 2);
    for (int idx = tid; idx < 256 * (KX / 2); idx += NTHR) { const int n = idx / (KX / 2), kc = (idx % (KX / 2)) * 2, jt = n >> 4, ho = n & 15; float v0, v1;
        if (kc < 256) { const int i = kc >> 4, hi = kc & 15; if (i <= jt) { v0 = kk[((jt - i) * 16 + ho) * 16 + hi]; v1 = kk[((jt - i) * 16 + ho) * 16 + hi + 1]; } else { v0 = 0.f; v1 = 0.f; } }
        else { const int p = (kc - 256) & 63; const f32x2 c0 = cc[ho * 64 + p], c1 = cc[ho * 64 + p + 1], w0 = pw[(jt + 1) * 64 + p], w1 = pw[(jt + 1) * 64 + p + 1];
            if (kc < 320) { v0 = c0.x * w0.x - c0.y * w0.y; v1 = c1.x * w1.x - c1.y * w1.y; } else { v0 = -(c0.x * w0.y + c0.y * w0.x); v1 = -(c1.x * w1.y + c1.y * w1.x); } }
        w2[idx] = pk2(v0, v1); }
    unsigned* fm = (unsigned*)(a.ws + WS_F) + (size_t)g * 128 * 128;
    for (int idx = tid; idx < 128 * 128; idx += NTHR) { const int n = idx >> 7, kc = (idx & 127) * 2, p = n & 63, i = kc >> 4, hi = kc & 15;
        const f32x2 w = pw[(15 - i) * 64 + p], q0 = bb[p * 16 + hi], q1 = bb[p * 16 + hi + 1]; float v0, v1;
        if (n < 64) { v0 = w.x * q0.x - w.y * q0.y; v1 = w.x * q1.x - w.y * q1.y; } else { v0 = w.x * q0.y + w.y * q0.x; v1 = w.x * q1.y + w.y * q1.x; }
        fm[idx] = pk2(v0, v1); }
    __syncthreads();
}

__device__ __forceinline__ void ssm_scan(unsigned char* ws_, LAS unsigned char* lds, const pg8::Order& S, int wave, int lane) {
    struct { unsigned char* ws; } a; a.ws = ws_;
    typedef float f32x2 __attribute__((ext_vector_type(2)));
    LAS f32x2* ex = (LAS f32x2*)lds;
    const float* Gb = (const float*)(a.ws + WS_BIG + BG_G); bf16_t* ue = (bf16_t*)(a.ws + WS_BIG + BG_UEXT);
    for (int i = 0; ; i += 2) {
        pg8::Unit u0, u1; if (!S.next(i, u0)) break; const bool has1 = S.next(i + 1, u1);
        const int bg = (wave >> 2) ? (has1 ? u1.pm : u0.pm) : u0.pm, seg = wave & 3, g = bg & 63, p = lane; const bool live = (wave >> 2) == 0 || has1;
        const f32x4 tb = *(const f32x4*)(a.ws + WS_TAB + ((size_t)g * 64 + p) * 16);
        const float* gp = Gb + ((size_t)bg * 256 + seg * 64) * 128 + p;
        float er = 0.f, ei = 0.f;
        for (int c0 = 0; c0 < 64; c0 += 16) { float gr[16], gi[16];
#pragma unroll
            for (int k = 0; k < 16; ++k) { gr[k] = gp[(size_t)(c0 + k) * 128]; gi[k] = gp[(size_t)(c0 + k) * 128 + 64]; }
#pragma unroll
            for (int k = 0; k < 16; ++k) { const float nr = tb[0] * er - tb[1] * ei + gr[k], ni = tb[0] * ei + tb[1] * er + gi[k]; er = nr; ei = ni; } }
        ex[wave * 64 + p] = (f32x2){er, ei};
        __syncthreads();
        float sr = 0.f, si = 0.f;
        for (int s = 0; s < seg; ++s) { const f32x2 e = ex[((wave & 4) + s) * 64 + p]; const float nr = tb[2] * sr - tb[3] * si + e.x, ni = tb[2] * si + tb[3] * sr + e.y; sr = nr; si = ni; }
        bf16_t* up = ue + ((size_t)bg * 256 + seg * 64) * KX + 256 + p;
        for (int c0 = 0; c0 < 64; c0 += 16) { float gr[16], gi[16];
#pragma unroll
            for (int k = 0; k < 16; ++k) { gr[k] = gp[(size_t)(c0 + k) * 128]; gi[k] = gp[(size_t)(c0 + k) * 128 + 64]; }
#pragma unroll
            for (int k = 0; k < 16; ++k) { if (live) { up[(size_t)(c0 + k) * KX] = (bf16_t)f2bf(sr); up[(size_t)(c0 + k) * KX + 64] = (bf16_t)f2bf(si); }
                const float nr = tb[0] * sr - tb[1] * si + gr[k], ni = tb[0] * si + tb[1] * sr + gi[k]; sr = nr; si = ni; } }
        __syncthreads();
    }
}

#define XB_TMO      128
#define XB_XCNT(j)  (256  + 64 * (j))
#define XB_XSUB(j)  (1280 + 64 * (j))
#define XB_XGEN(j)  (2304 + 64 * (j))
#define XB_TOP      3328
#define XB_TOPGEN   3392
#define XCD_BAR_WORDS 3456
#define XB_SPIN_CAP (1u << 22)
__device__ __forceinline__ unsigned xb_ld(unsigned* p)              { return __hip_atomic_load(p, __ATOMIC_RELAXED, __HIP_MEMORY_SCOPE_AGENT); }
__device__ __forceinline__ unsigned xb_add(unsigned* p, unsigned v) { return __hip_atomic_fetch_add(p, v, __ATOMIC_RELAXED, __HIP_MEMORY_SCOPE_AGENT); }
__device__ __forceinline__ unsigned xb_xcc_id() { return (unsigned)__builtin_amdgcn_s_getreg((3 << 11) | 20) & 0xFu; }
#define XB_SPIN(cond, bar) do { unsigned _sp = 0; while (cond) { __builtin_amdgcn_s_sleep(1); \
    if ((++_sp & 255u) == 0u) { if (xb_ld(&(bar)[XB_TMO])) break; if (_sp > XB_SPIN_CAP) { atomicAdd(&(bar)[XB_TMO], 1u); break; } } } } while (0)
struct XcdBarrier { unsigned* bar; unsigned x; volatile LAS unsigned* st; };
__device__ __forceinline__ XcdBarrier xcd_barrier_post(unsigned* bar, volatile LAS unsigned* st) {
    XcdBarrier b; b.bar = bar; b.x = xb_xcc_id(); b.st = st;
    if (threadIdx.x == 0) (void)xb_add(&bar[XB_XCNT(b.x)], 1u);
    return b;
}
__device__ __forceinline__ void xcd_barrier_complete(unsigned* bar, unsigned x, unsigned& nloc, unsigned& nx) {
    const unsigned G = gridDim.x * gridDim.y * gridDim.z;
    unsigned sum, cnt, mine, sp = 0u;
    for (;;) {
        sum = 0u; cnt = 0u; mine = 0u;
#pragma unroll
        for (unsigned j = 0; j < 16; ++j) { const unsigned c = xb_ld(&bar[XB_XCNT(j)]); sum += c; cnt += (c > 0u) ? 1u : 0u; mine = (j == x) ? c : mine; }
        if (sum == G) break;
        __builtin_amdgcn_s_sleep(1);
        if ((++sp & 255u) == 0u) { if (xb_ld(&bar[XB_TMO])) break; if (sp > XB_SPIN_CAP) { atomicAdd(&bar[XB_TMO], 1u); break; } }
    }
    nloc = mine > 0u ? mine : 1u; nx = cnt > 0u ? cnt : 1u;
}
__device__ __forceinline__ void xcd_barrier(const XcdBarrier& b) {
    asm volatile("s_waitcnt vmcnt(0)" ::: "memory");
    __syncthreads();
    if (threadIdx.x == 0) {
        unsigned* bar = b.bar;
        __builtin_amdgcn_s_waitcnt(0);
        unsigned nloc = b.st[0], nx = b.st[1];
        if (nloc == 0u) { xcd_barrier_complete(bar, b.x, nloc, nx); b.st[0] = nloc; b.st[1] = nx; }
        const unsigned old = xb_add(&bar[XB_XSUB(b.x)], 1u);
        const unsigned gen = old / nloc;
        if (old + 1u == (gen + 1u) * nloc) {
            __builtin_amdgcn_fence(__ATOMIC_RELEASE, "agent");
            asm volatile("s_waitcnt vmcnt(0)" ::: "memory");
            const unsigned og = xb_add(&bar[XB_TOP], 1u);
            const unsigned tg = og / nx;
            if (og + 1u == (tg + 1u) * nx) xb_add(&bar[XB_TOPGEN], 1u);
            else XB_SPIN(xb_ld(&bar[XB_TOPGEN]) == tg, bar);
            __builtin_amdgcn_fence(__ATOMIC_ACQUIRE, "agent");
            xb_add(&bar[XB_XGEN(b.x)], 1u);
            asm volatile("s_waitcnt vmcnt(0)" ::: "memory");
        } else {
            XB_SPIN(xb_ld(&bar[XB_XGEN(b.x)]) == gen, bar);
            __builtin_amdgcn_fence(__ATOMIC_ACQUIRE, "agent");
            asm volatile("s_waitcnt vmcnt(0)" ::: "memory");
        }
    }
    __syncthreads();
}

enum { PH_P0 = 0, PH_KVK, PH_KVV, PH_SSM1, PH_SCAN, PH_SSM3, PH_GLU, PH_Q, PH_SP, PH_OV, PH_WO, PH_UP, PH_DOWN, PH_CONVIN, PH_CONV, PH_CONVOUT, PH_NORM2, PH_FINAL };
constexpr int NPROG = 43;
#ifndef PROBE_REP_MASK
#define PROBE_REP_MASK 0u
#endif
#ifndef PROBE_P0_PARTS
#define PROBE_P0_PARTS 0u
#endif
#ifndef PROBE_SYNC_REP
#define PROBE_SYNC_REP 1
#endif

__global__ void __launch_bounds__(NTHR, 2) mega_fwd(Args a) {
    extern __shared__ __attribute__((aligned(16))) unsigned char lds_raw[];
    cg::grid_group grid = cg::this_grid();
    LAS unsigned char* lds = (LAS unsigned char*)lds_raw;
    const int Gn = gridDim.x, bx = blockIdx.x, wave0 = __builtin_amdgcn_readfirstlane((int)(threadIdx.x >> 6));
    const int vcu = (Gn % 8 == 0) ? (bx % 8) * (Gn / 8) + bx / 8 : bx;
    const int NGW = Gn * NWAVES;
#define AS4 __attribute__((address_space(4)))
    { unsigned char* ws = a.ws;
    if (threadIdx.x < 8) ((LAS unsigned*)(lds + 131072 + 64))[threadIdx.x] = 0u;
    __syncthreads();
    (void)xcd_barrier_post((unsigned*)(ws + WS_BAR), (volatile LAS unsigned*)(lds + 131072 + 64)); }

#pragma nounroll
    for (int pi = 0; pi < NPROG; ++pi) {
        int ph, l = 0;
        if (pi < 3) ph = pi;
        else { int q = pi - 3;
            if (q == 19) ph = PH_NORM2; else if (q == 39) ph = PH_FINAL;
            else { if (q >= 20) { q -= 20; l = 2; } int r = q; if (q >= 10) { r = q - 10; l += 1; }
                if (l & 1) ph = (r < 3) ? PH_CONVIN + r : PH_Q + (r - 3); else ph = (r < 4) ? PH_SSM1 + r : PH_Q + (r - 4); } }
        const int j = l >> 1;
        const AS4 char* kp = (const AS4 char*)__builtin_amdgcn_kernarg_segment_ptr(); asm volatile("" : "+s"(kp));
#define INP(k) (*(const float* const AS4*)(kp + 8 * (k)))
        unsigned char* const ws = *(unsigned char* const AS4*)(kp + 200);
        float* const xres = *(float* const AS4*)(kp + 192);
        bf16_t* const XG = (bf16_t*)(ws + WS_XG);
        unsigned char* const big = ws + WS_BIG;
        int lanev = (int)__builtin_amdgcn_mbcnt_hi(~0u, __builtin_amdgcn_mbcnt_lo(~0u, 0u)); asm volatile("" : "+v"(lanev));
        const int lane = lanev, wave = wave0, tid = wave * 64 + lane, gw = vcu * NWAVES + wave;
        bool is_gemm = true, do_sync = true, local_seam = false;
        pg8::Order S; pg8::Epi E; int lda = D, ldb = D, K = D;
        S.G = Gn; S.c = bx; S.an = 0; S.bb = 0; S.bg = 0; S.nM = T / 256; S.nN = 4; S.A = nullptr; S.B = nullptr; S.am = 256L * D * 2; S.bn = 256L * D * 2;
        E.mode = pg8::M_STORE; E.ldc = D; E.mul = 1.0f; E.o0 = nullptr; E.o1 = nullptr; E.f0 = nullptr; E.f1 = nullptr; E.f2 = nullptr; E.b0 = nullptr; E.sin = nullptr; E.sout = nullptr;
        unsigned long long* const SSb = (unsigned long long*)(ws + WS_SS); unsigned long long* const Lb = (unsigned long long*)(ws + WS_L) + (size_t)l * T * 4;
        const int nrep_ng = ((PROBE_REP_MASK >> ph) & 1u) ? 2 : 1;
#pragma nounroll
        for (int rpn = 0; rpn < nrep_ng; ++rpn)
        switch (ph) {
        case PH_P0: { is_gemm = false;
            { f32x4* z = (f32x4*)ws; const f32x4 zero = {0.f, 0.f, 0.f, 0.f}; for (int i = bx * NTHR + tid; i < (int)(WS_ZERO_BYTES / 16); i += Gn * NTHR) z[i] = zero; }
            LAS float* scr = (LAS float*)(lds + wave * 8448);
#pragma nounroll
            for (int rq = 0; rq < ((PROBE_P0_PARTS & 1u) ? 2 : 1); ++rq)
            for (int it = gw; it < 30720; it += NGW) {
                int r = it, idx, K_ = 1024, N_ = 1024, typ; const float* src; const float* gain = nullptr;
                if (r < 2048) { idx = r >> 10; r &= 1023; src = INP(14) + (size_t)idx * 1024 * 2048; N_ = 2048; typ = 0; }
                else if ((r -= 2048) < 3072) { idx = r / 1536; r %= 1536; src = INP(15) + (size_t)idx * 1024 * 3072; N_ = 3072; typ = 1; gain = INP(3) + (size_t)(2 * idx + 1) * D; }
                else if ((r -= 3072) < 1024) { idx = r >> 9; r &= 511; src = INP(17) + (size_t)idx * 1024 * 1024; typ = 2; }
                else if ((r -= 1024) < 2048) { idx = r >> 9; r &= 511; src = INP(18) + (size_t)idx * 1024 * 1024; typ = 3; gain = INP(4) + (size_t)idx * D; }
                else if ((r -= 2048) < 4096) { idx = r >> 10; r &= 1023; src = INP(19) + (size_t)idx * 1024 * 2048; N_ = 2048; typ = 4; }
                else if ((r -= 4096) < 2048) { idx = r >> 9; r &= 511; src = INP(20) + (size_t)idx * 1024 * 1024; typ = 5; }
                else if ((r -= 2048) < 8192) { idx = r >> 11; r &= 2047; src = INP(21) + (size_t)idx * 1024 * 4096; N_ = 4096; typ = 6; gain = INP(5) + (size_t)idx * D; }
                else { r -= 8192; idx = r >> 11; r &= 2047; src = INP(22) + (size_t)idx * 4096 * 1024; K_ = 4096; typ = 7; }
                const int nblk = N_ / 32, kb = r / nblk, nb = r % nblk, k0 = 64 * kb, n0 = 32 * nb; bf16_t* dst;
                switch (typ) {
                case 0: { const int n1 = n0 & 1023, row = (n1 >> 7) * 256 + (n0 >= 1024 ? 128 : 0) + (n1 & 127); dst = (bf16_t*)(ws + WS_WGLU) + ((size_t)idx * 2048 + row) * 1024; } break;
                case 1: { int row; if (n0 < 1024) row = n0; else { const int n1 = (n0 - 1024) & 1023; row = 1024 + (n1 >> 7) * 256 + (n0 >= 2048 ? 128 : 0) + (n1 & 127); } dst = (bf16_t*)(ws + WS_WIN) + ((size_t)idx * 3072 + row) * 1024; } break;
                case 2: dst = (bf16_t*)(ws + WS_WOUT) + ((size_t)idx * 1024 + n0) * 1024; break;
                case 3: dst = (bf16_t*)(ws + WS_WQ) + ((size_t)idx * 1024 + n0) * 1024; break;
                case 4: dst = (n0 < 1024) ? (bf16_t*)(ws + WS_WK) + ((size_t)idx * 1024 + n0) * 1024 : (bf16_t*)(ws + WS_WV) + ((size_t)idx * 1024 + n0 - 1024) * 1024; break;
                case 5: dst = (bf16_t*)(ws + WS_WO) + ((size_t)idx * 1024 + n0) * 1024; break;
                case 6: dst = (bf16_t*)(ws + WS_W1) + ((size_t)idx * 4096 + n0) * 1024; break;
                default: dst = (bf16_t*)(ws + WS_W2) + ((size_t)idx * 1024 + n0) * 4096; break;
                }
                transpose_item(src, K_, N_, dst, k0, n0, gain, scr, lane);
            }
            for (int m = gw; m < BATCH * NMEM; m += NGW) { f32x4 v[4]; rms_row(INP(1) + (size_t)m * D, INP(2), lane, v); u32x2* o = (u32x2*)((bf16_t*)(ws + WS_MEMN) + (size_t)m * D) + lane;
#pragma unroll
                for (int jj = 0; jj < 4; ++jj) { u32x2 w; w.x = pk2(v[jj][0], v[jj][1]); w.y = pk2(v[jj][2], v[jj][3]); o[64 * jj] = w; } }
            __syncthreads();
#pragma nounroll
            for (int rq = 0; rq < ((PROBE_P0_PARTS & 2u) ? 2 : 1); ++rq)
            for (int ci = bx; ci < BATCH * NCH; ci += Gn) norm_chunk_to_uext<false>(INP(0), INP(3), (bf16_t*)(big + BG_UEXT), ci, lds, wave, lane);
            { SsmIn si{INP(6), INP(7), INP(8), INP(9), INP(10), INP(11), INP(12), ws}; for (int rq = 0; rq < ((PROBE_P0_PARTS & 4u) ? 2 : 1); ++rq) for (int g = bx; g < SG; g += Gn) build_ssm(si, 0, g, lds, tid); }
        } break;
        case PH_KVK: S.nM = BATCH * NMEM / 256; S.nN = 16; S.A = (const char*)(ws + WS_MEMN); S.B = (const char*)(ws + WS_WK); E.o0 = (bf16_t*)(ws + WS_KB); E.ldc = 4096; do_sync = false; break;
        case PH_KVV: S.nM = 16; S.nN = BATCH * NMEM / 256; S.A = (const char*)(ws + WS_WV); S.B = (const char*)(ws + WS_MEMN); E.o0 = (bf16_t*)(ws + WS_VT); E.ldc = 2048; S.c = (bx + Gn / 2) % Gn; do_sync = false; break;
        case PH_SSM1: S.nM = BATCH * SG; S.nN = 1; S.A = (const char*)(big + BG_UEXT); S.am = 256L * KX * 2; S.B = (const char*)(ws + WS_F); S.bn = 0; S.bg = 128L * 256 * 2; lda = KX; ldb = 256; K = 256;
            E.mode = pg8::M_G; E.f2 = (float*)(big + BG_G); local_seam = true; break;
        case PH_SCAN: is_gemm = false; local_seam = true; S.nM = BATCH * SG; S.nN = 1; S.nwg = S.nM; ssm_scan(ws, lds, S, wave, lane); break;
        case PH_SSM3: S.nM = BATCH * SG; S.nN = 1; S.A = (const char*)(big + BG_UEXT); S.am = 256L * KX * 2; S.B = (const char*)(ws + WS_W2X); S.bn = 0; S.bg = 256L * KX * 2; lda = KX; ldb = KX; K = KX;
            E.mode = pg8::M_Y; E.o0 = (bf16_t*)(big + BG_Y); E.b0 = (const bf16_t*)(big + BG_UEXT); E.f1 = INP(13) + (size_t)j * D; break;
        case PH_GLU: S.nN = 8; S.A = (const char*)(big + BG_Y); S.B = (const char*)(ws + WS_WGLU + (size_t)j * 2048 * 1024 * 2);
            E.mode = pg8::M_GLU; E.f0 = (l == 0) ? INP(0) : nullptr; E.o0 = XG; E.sout = SSb + (size_t)(l * 3 + 1) * T; break;
        case PH_Q: S.A = (const char*)XG; S.B = (const char*)(ws + WS_WQ + (size_t)l * 1024 * 1024 * 2);
            E.mode = pg8::M_SCALE; E.o0 = (bf16_t*)(big + BG_Q); E.sin = SSb + (size_t)(l * 3 + 1) * T; E.mul = 0.0625f * 1.4426950409f; local_seam = true; break;
        case PH_SP: S.A = (const char*)(big + BG_Q); S.an = 256 * 2; S.B = (const char*)(ws + WS_KB + (size_t)l * 1024 * 2); S.bn = 256 * 2; S.bb = 256L * 4096 * 2; ldb = 4096; K = 256;
            E.mode = pg8::M_P; E.o0 = (bf16_t*)(big + BG_P); E.sout = Lb; local_seam = true; break;
        case PH_OV: S.A = (const char*)(big + BG_P); S.an = 256 * 2; S.B = (const char*)(ws + WS_VT + (size_t)l * 1024 * 2048 * 2); S.bn = 256L * 2048 * 2; S.bb = 256 * 2; ldb = 2048; K = 256;
            E.mode = pg8::M_O; E.o0 = (bf16_t*)(big + BG_Q); E.sin = Lb; break;
        case PH_WO: S.A = (const char*)(big + BG_Q); S.B = (const char*)(ws + WS_WO + (size_t)l * 1024 * 1024 * 2);
            E.mode = pg8::M_RES; E.o0 = XG; E.sout = SSb + (size_t)(l * 3 + 2) * T; break;
        case PH_UP: S.nN = 16; S.A = (const char*)XG; S.B = (const char*)(ws + WS_W1 + (size_t)l * 4096 * 1024 * 2);
            E.mode = pg8::M_UP; E.o0 = (bf16_t*)(big + BG_H); E.ldc = FF; E.sin = SSb + (size_t)(l * 3 + 2) * T; break;
        case PH_DOWN: S.A = (const char*)(big + BG_H); S.am = 256L * FF * 2; S.B = (const char*)(ws + WS_W2 + (size_t)l * 4096 * 1024 * 2); S.bn = 256L * FF * 2; lda = FF; ldb = FF; K = FF;
            E.mode = pg8::M_RES; E.o0 = XG;
            if ((l & 1) == 0) E.sout = SSb + (size_t)((l + 1) * 3) * T; break;
        case PH_CONVIN: S.nN = 12; S.A = (const char*)XG; S.B = (const char*)(ws + WS_WIN + (size_t)j * 3072 * 1024 * 2);
            E.mode = pg8::M_CONVIN; E.o0 = (bf16_t*)(big + BG_BC); E.o1 = (bf16_t*)(big + BG_Z); E.sin = SSb + (size_t)(l * 3) * T; break;
        case PH_CONV: { is_gemm = false;
            const bf16_t* Bc = (const bf16_t*)(big + BG_BC); const bf16_t* Z = (const bf16_t*)(big + BG_Z); bf16_t* Uc = (bf16_t*)(big + BG_UC); const float* cw = INP(16) + (size_t)j * 3 * D;
            for (int i = bx * NTHR + tid; i < T * 128; i += Gn * NTHR) { const int t = i >> 7, c8 = (i & 127) * 8, tl = t & (SEQ - 1); const size_t off = (size_t)t * D + c8;
                const u32x4 z0 = *(const u32x4*)(Z + off), bv = *(const u32x4*)(Bc + off); u32x4 z1 = {0u, 0u, 0u, 0u}, z2 = {0u, 0u, 0u, 0u};
                if (tl >= 1) z1 = *(const u32x4*)(Z + off - D); if (tl >= 2) z2 = *(const u32x4*)(Z + off - 2 * D);
                f32x4 o0, o1;
#pragma unroll
                for (int q = 0; q < 4; ++q) { const int cc = c8 + 2 * q;
                    const float w0a = cw[cc], w0b = cw[cc + 1], w1a = cw[D + cc], w1b = cw[D + cc + 1], w2a = cw[2 * D + cc], w2b = cw[2 * D + cc + 1];
                    const float ra = pg8::bf_lo(bv[q]) * (w0a * pg8::bf_lo(z2[q]) + w1a * pg8::bf_lo(z1[q]) + w2a * pg8::bf_lo(z0[q]));
                    const float rb = pg8::bf_hi(bv[q]) * (w0b * pg8::bf_hi(z2[q]) + w1b * pg8::bf_hi(z1[q]) + w2b * pg8::bf_hi(z0[q]));
                    if (q < 2) { o0[2 * q] = ra; o0[2 * q + 1] = rb; } else { o1[2 * (q - 2)] = ra; o1[2 * (q - 2) + 1] = rb; } }
                *(u32x4*)(Uc + off) = pg8::pack8(o0, o1); }
        } break;
        case PH_CONVOUT: S.A = (const char*)(big + BG_UC); S.B = (const char*)(ws + WS_WOUT + (size_t)j * 1024 * 1024 * 2);
            E.mode = pg8::M_RES; E.o0 = XG; E.sout = SSb + (size_t)(l * 3 + 1) * T; break;
        case PH_NORM2: is_gemm = false;
            for (int ci = bx; ci < BATCH * NCH; ci += Gn) norm_chunk_to_uext<true>(XG, INP(3) + 2 * D, (bf16_t*)(big + BG_UEXT), ci, lds, wave, lane);
            { SsmIn si{INP(6), INP(7), INP(8), INP(9), INP(10), INP(11), INP(12), ws}; for (int g = bx; g < SG; g += Gn) build_ssm(si, 1, g, lds, tid); }
            break;
        default: is_gemm = false;
            for (int m = gw; m < T; m += NGW) { f32x4 v[4]; rms_row_bf(XG + (size_t)m * D, INP(23), lane, v); f32x4* o = (f32x4*)(xres + (size_t)m * D) + lane;
#pragma unroll
                for (int jj = 0; jj < 4; ++jj) o[64 * jj] = v[jj]; }
            do_sync = false; break;
        }
        S.nwg = S.nM * S.nN;
        if (is_gemm) { const int nrep = ((PROBE_REP_MASK >> ph) & 1u) ? 2 : 1;
#pragma nounroll
            for (int rp = 0; rp < nrep; ++rp) pg8::gemm_phase<pg8::Epi, pg8::Order, true, true>(lds, lda, ldb, K, S, E, tid); }
        if (do_sync) {
            if (local_seam) {
                asm volatile("s_waitcnt vmcnt(0)" ::: "memory"); __builtin_amdgcn_fence(__ATOMIC_ACQUIRE, "agent"); asm volatile("s_waitcnt vmcnt(0)" ::: "memory"); __syncthreads();
            } else if (pi == 0) {
                __builtin_amdgcn_fence(__ATOMIC_RELEASE, "agent"); asm volatile("s_waitcnt vmcnt(0)" ::: "memory");
#pragma nounroll
                for (int sr = 0; sr < PROBE_SYNC_REP; ++sr) grid.sync();
                __builtin_amdgcn_fence(__ATOMIC_ACQUIRE, "agent"); asm volatile("s_waitcnt vmcnt(0)" ::: "memory");
            } else {
#pragma nounroll
                for (int sr = 0; sr < PROBE_SYNC_REP; ++sr) { unsigned* barp = (unsigned*)(ws + WS_BAR); XcdBarrier xb; xb.bar = barp; xb.x = xb_xcc_id(); xb.st = (volatile LAS unsigned*)(lds + 131072 + 64); xcd_barrier(xb); }
            }
        }
    }
}

extern "C" void kernel_launch(void* const* d_in, const int* in_sizes, int n_in, void* d_out, int out_size, void* d_ws, size_t ws_size, hipStream_t stream) {
    static int grid = 0;
    if (grid == 0) {
        if (n_in != 24 || out_size != T * D || ws_size < WS_END) { fprintf(stderr, "kernel_launch: unexpected shapes (n_in %d out %d ws %zu)\n", n_in, out_size, ws_size); grid = -1; return; }
        int dev = 0, cus = 0, per_cu = 0;
        (void)hipGetDevice(&dev); (void)hipDeviceGetAttribute(&cus, hipDeviceAttributeMultiprocessorCount, dev);
        if (hipFuncSetAttribute((const void*)mega_fwd, hipFuncAttributeMaxDynamicSharedMemorySize, LDS_BYTES) != hipSuccess) { fprintf(stderr, "kernel_launch: hipFuncSetAttribute failed\n"); grid = -1; return; }
        if (hipOccupancyMaxActiveBlocksPerMultiprocessor(&per_cu, (const void*)mega_fwd, NTHR, LDS_BYTES) != hipSuccess || per_cu < 1) { (void)hipGetLastError(); per_cu = 1; }
        grid = cus * per_cu;
        fprintf(stderr, "kernel_launch: %d CUs x %d blocks/CU\n", cus, per_cu);
    }
    if (grid < 0) return;
    if (hipMemsetAsync((char*)d_ws + WS_BAR, 0, XCD_BAR_WORDS * 4, stream) != hipSuccess) { fprintf(stderr, "kernel_launch: memset failed\n"); return; }
    Args a{};
    for (int i = 0; i < 24; ++i) a.in[i] = (const float*)d_in[i];
    a.out = (float*)d_out; a.ws = (unsigned char*)d_ws;
    void* kargs[] = {&a};
    hipError_t e = hipLaunchCooperativeKernel((const void*)mega_fwd, dim3(grid), dim3(NTHR), kargs, LDS_BYTES, stream);
    if (e != hipSuccess) fprintf(stderr, "kernel_launch: cooperative launch failed: %s (grid %d)\n", hipGetErrorString(e), grid);
}
```

```cpp
#include <hip/hip_runtime.h>
#include <hip/hip_cooperative_groups.h>
#include <cstdio>
#include <cstdint>
namespace cg = cooperative_groups;

namespace pg8 {
#define PG8_LAS __attribute__((address_space(3)))
typedef unsigned short bf16_t;
typedef short bf16x8 __attribute__((ext_vector_type(8)));
typedef float f32x4 __attribute__((ext_vector_type(4)));
typedef unsigned u32x4 __attribute__((ext_vector_type(4)));
typedef unsigned u32x2 __attribute__((ext_vector_type(2)));
constexpr int BM = 256, BK = 64, HALF = 128, HTB = HALF * BK * 2  , STAGE_BYTES = 8 * HTB, NXCD = 8, WGM = 8;

__host__ __device__ __forceinline__ int lds_byte(int r, int c) { const int st = (r >> 4) * 2 + (c >> 5), rr = r & 15, cc = c & 31, ob = rr * 64 + cc * 2; return st * 1024 + (ob ^ (((ob >> 9) & 1) << 5)); }
__host__ __device__ __forceinline__ void stage_rc(int b, int& R, int& C) { const int st = b / 1024, sb = b % 1024, swz = sb ^ (((sb >> 9) & 1) << 5); R = (st >> 1) * 16 + swz / 64; C = (st & 1) * 32 + (swz % 64) / 2; }
__host__ __device__ __forceinline__ int perm32(int rho) { const int n = rho >> 4, i = rho & 15; return 8 * (i >> 2) + 4 * n + (i & 3); }

struct Unit { int pm, pn; };

struct Order {
    int nM, nN, nwg, G, c, ash, amask, bsh, bmask; const char* A; const char* B; long am, am2, an, bn, bb, bg;
    __device__ __forceinline__ bool next(int i, Unit& u) const {
        const long L = (long)i * G + c; if (L >= nwg) return false;
        int wgid = (int)L; { const int q = nwg / NXCD, r = nwg % NXCD, xcd = wgid % NXCD, off = wgid / NXCD; wgid = (xcd < r ? xcd * (q + 1) : r * (q + 1) + (xcd - r) * q) + off; }
        const int nig = WGM * nN, gid = wgid / nig, fm = gid * WGM, gsz = (nM - fm) < WGM ? (nM - fm) : WGM;
        u.pm = fm + ((wgid % nig) % gsz); u.pn = (wgid % nig) / gsz; return true;
    }
    __device__ __forceinline__ const char* abase(const Unit& u) const { return A + (long)(u.pm >> ash) * am + (long)(u.pm & amask) * am2 + (long)u.pn * an; }
    __device__ __forceinline__ const char* bbase(const Unit& u) const { return B + (long)u.pn * bn + (long)(u.pm >> bsh) * bb + (long)(u.pm & bmask) * bg; }
};

__device__ __forceinline__ unsigned cvt_pk_bf16(float lo, float hi) { unsigned r; asm volatile("v_cvt_pk_bf16_f32 %0, %1, %2" : "=v"(r) : "v"(lo), "v"(hi)); return r; }
__device__ __forceinline__ u32x4 pack8(const f32x4 a, const f32x4 b) { u32x4 w; w.x = cvt_pk_bf16(a[0], a[1]); w.y = cvt_pk_bf16(a[2], a[3]); w.z = cvt_pk_bf16(b[0], b[1]); w.w = cvt_pk_bf16(b[2], b[3]); return w; }
__device__ __forceinline__ float bf_lo(unsigned w) { return __uint_as_float(w << 16); }
__device__ __forceinline__ float bf_hi(unsigned w) { return __uint_as_float(w & 0xffff0000u); }

enum { M_STORE = 0, M_SCALE, M_UP, M_CONVIN, M_RES, M_GLU, M_SOFT, M_STORE_N, M_G, M_Y };
__device__ __forceinline__ float gelu_tanh(float y) {
    const float z = 0.7978845608f * (y + 0.044715f * y * y * y);
    const float e = __builtin_amdgcn_exp2f(z * 2.8853900818f);
    const float t = 1.0f - 2.0f * __builtin_amdgcn_rcpf(1.0f + e);
    return 0.5f * y * (1.0f + t);
}
struct Epi {
    static constexpr bool PERM = true;
    int mode, ldc; float mul;
    bf16_t* o0; bf16_t* o1; const float* f0; const float* f1; float* f2; const bf16_t* b0;
    const unsigned long long* sin; unsigned long long* sout;
    __device__ __forceinline__ void operator()(f32x4 (&acc)[2][2][4][2], const Unit& u, int wr, int wc, int fr, int fq, PG8_LAS unsigned char* xlds) const {
        const int r0 = u.pm * 256 + wr * 64 + fr;
        const int cw = wc * 32 + 8 * fq;
        if (mode == M_STORE || mode == M_SCALE || mode == M_UP) {
            float rs[8];
            if (mode != M_STORE) { unsigned long long sv[8];
#pragma unroll
                for (int i = 0; i < 8; ++i) sv[i] = sin[r0 + (i >> 2) * 128 + (i & 3) * 16];
#pragma unroll
                for (int i = 0; i < 8; ++i) rs[i] = __builtin_amdgcn_rsqf((float)sv[i] * (1.0f / (1024.0f * 1048576.0f)) + 1e-6f) * mul;
            } else {
#pragma unroll
                for (int i = 0; i < 8; ++i) rs[i] = 1.0f; }
#pragma unroll
            for (int ai = 0; ai < 2; ++ai)
#pragma unroll
                for (int m = 0; m < 4; ++m) { const int row = r0 + ai * 128 + m * 16; const float r_ = rs[ai * 4 + m];
                    bf16_t* rowp = o0 + (size_t)row * ldc + u.pn * 256 + cw;
#pragma unroll
                    for (int bj = 0; bj < 2; ++bj) { f32x4 v0 = acc[ai][bj][m][0] * r_, v1 = acc[ai][bj][m][1] * r_;
                        if (mode == M_UP) {
#pragma unroll
                            for (int j = 0; j < 4; ++j) { const float a = fmaxf(v0[j], 0.f), b = fmaxf(v1[j], 0.f); v0[j] = a * a; v1[j] = b * b; } }
                        *(u32x4*)(rowp + bj * 128) = pack8(v0, v1); } }
        } else if (mode == M_CONVIN) {
            float rs[8]; { unsigned long long sv[8];
#pragma unroll
                for (int i = 0; i < 8; ++i) sv[i] = sin[r0 + (i >> 2) * 128 + (i & 3) * 16];
#pragma unroll
                for (int i = 0; i < 8; ++i) rs[i] = __builtin_amdgcn_rsqf((float)sv[i] * (1.0f / (1024.0f * 1048576.0f)) + 1e-6f); }
#pragma unroll
            for (int ai = 0; ai < 2; ++ai)
#pragma unroll
                for (int m = 0; m < 4; ++m) { const int row = r0 + ai * 128 + m * 16; const float r_ = rs[ai * 4 + m];
                    if (u.pn < 4) { bf16_t* rowp = o0 + (size_t)row * 1024 + u.pn * 256 + cw;
#pragma unroll
                        for (int bj = 0; bj < 2; ++bj) *(u32x4*)(rowp + bj * 128) = pack8(acc[ai][bj][m][0] * r_, acc[ai][bj][m][1] * r_);
                    } else { bf16_t* rowp = o1 + (size_t)row * 1024 + (u.pn - 4) * 128 + cw; const float r2 = r_ * r_;
                        *(u32x4*)rowp = pack8(acc[ai][0][m][0] * acc[ai][1][m][0] * r2, acc[ai][0][m][1] * acc[ai][1][m][1] * r2); } }
        } else if (mode == M_RES) {
            bf16_t* const xb = o0 + (size_t)r0 * 1024 + u.pn * 256 + cw;
#pragma unroll
            for (int ai = 0; ai < 2; ++ai) { u32x4 xw[4][2];
#pragma unroll
                for (int m = 0; m < 4; ++m)
#pragma unroll
                    for (int bj = 0; bj < 2; ++bj) xw[m][bj] = *(const u32x4*)(xb + (size_t)(ai * 128 + m * 16) * 1024 + bj * 128);
                asm volatile("" ::: "memory");
#pragma unroll
                for (int m = 0; m < 4; ++m) { float ssq = 0.f;
#pragma unroll
                    for (int bj = 0; bj < 2; ++bj) { const u32x4 w = xw[m][bj];
                        f32x4 v0 = acc[ai][bj][m][0], v1 = acc[ai][bj][m][1];
                        v0[0] += bf_lo(w.x); v0[1] += bf_hi(w.x); v0[2] += bf_lo(w.y); v0[3] += bf_hi(w.y); v1[0] += bf_lo(w.z); v1[1] += bf_hi(w.z); v1[2] += bf_lo(w.w); v1[3] += bf_hi(w.w);
                        ssq += (v0[0] * v0[0] + v0[1] * v0[1]) + (v0[2] * v0[2] + v0[3] * v0[3]) + (v1[0] * v1[0] + v1[1] * v1[1]) + (v1[2] * v1[2] + v1[3] * v1[3]);
                        *(u32x4*)(xb + (size_t)(ai * 128 + m * 16) * 1024 + bj * 128) = pack8(v0, v1); }
                    if (sout) { ssq += __shfl_xor(ssq, 16); ssq += __shfl_xor(ssq, 32); if (fq == 0) atomicAdd(sout + r0 + ai * 128 + m * 16, (unsigned long long)(ssq * 1048576.0f + 0.5f)); } } }
        } else if (mode == M_GLU) {
            const size_t off0 = (size_t)r0 * 1024 + u.pn * 128 + cw;
#pragma unroll
            for (int ai = 0; ai < 2; ++ai) { f32x4 xv[4][2];
                if (f0) {
#pragma unroll
                    for (int m = 0; m < 4; ++m) { xv[m][0] = *(const f32x4*)(f0 + off0 + (size_t)(ai * 128 + m * 16) * 1024); xv[m][1] = *(const f32x4*)(f0 + off0 + (size_t)(ai * 128 + m * 16) * 1024 + 4); }
                } else { u32x4 xw[4];
#pragma unroll
                    for (int m = 0; m < 4; ++m) xw[m] = *(const u32x4*)(o0 + off0 + (size_t)(ai * 128 + m * 16) * 1024);
#pragma unroll
                    for (int m = 0; m < 4; ++m) { xv[m][0] = (f32x4){bf_lo(xw[m].x), bf_hi(xw[m].x), bf_lo(xw[m].y), bf_hi(xw[m].y)}; xv[m][1] = (f32x4){bf_lo(xw[m].z), bf_hi(xw[m].z), bf_lo(xw[m].w), bf_hi(xw[m].w)}; } }
                asm volatile("" ::: "memory");
#pragma unroll
                for (int m = 0; m < 4; ++m) { f32x4 v[2]; float ssq = 0.f; v[0] = xv[m][0]; v[1] = xv[m][1];
#pragma unroll
                    for (int n = 0; n < 2; ++n) { const f32x4 val = acc[ai][0][m][n], gate = acc[ai][1][m][n];
#pragma unroll
                        for (int j = 0; j < 4; ++j) { const float sg = __builtin_amdgcn_rcpf(1.0f + __builtin_amdgcn_exp2f(-1.4426950409f * gate[j])); v[n][j] += val[j] * sg; ssq += v[n][j] * v[n][j]; } }
                    *(u32x4*)(o0 + off0 + (size_t)(ai * 128 + m * 16) * 1024) = pack8(v[0], v[1]);
                    ssq += __shfl_xor(ssq, 16); ssq += __shfl_xor(ssq, 32); if (fq == 0) atomicAdd(sout + r0 + ai * 128 + m * 16, (unsigned long long)(ssq * 1048576.0f + 0.5f)); } }
        } else if (mode == M_SOFT) {
            PG8_LAS float* PS = (PG8_LAS float*)xlds + (wr * 64 + fr) * 4;
            const unsigned long long* sp = sin + r0;
#pragma unroll
            for (int ai = 0; ai < 2; ++ai)
#pragma unroll
                for (int m = 0; m < 4; ++m) { float sm = 0.f; const float r_ = __builtin_amdgcn_rsqf((float)sp[ai * 128 + m * 16] * (1.0f / (1024.0f * 1048576.0f)) + 1e-6f) * mul;
#pragma unroll
                    for (int bj = 0; bj < 2; ++bj)
#pragma unroll
                        for (int n = 0; n < 2; ++n)
#pragma unroll
                            for (int j = 0; j < 4; ++j) sm += __builtin_amdgcn_exp2f(acc[ai][bj][m][n][j] * r_);
                    sm += __shfl_xor(sm, 16); sm += __shfl_xor(sm, 32);
                    if (fq == 0) PS[(ai * 128 + m * 16) * 4 + wc] = sm; }
            asm volatile("s_waitcnt lgkmcnt(0)" ::: "memory"); __builtin_amdgcn_s_barrier(); asm volatile("" ::: "memory");
#pragma unroll
            for (int ai = 0; ai < 2; ++ai)
#pragma unroll
                for (int m = 0; m < 4; ++m) { const f32x4 ps = *(const PG8_LAS f32x4*)(PS + (ai * 128 + m * 16) * 4);
                    const float r_ = __builtin_amdgcn_rsqf((float)sp[ai * 128 + m * 16] * (1.0f / (1024.0f * 1048576.0f)) + 1e-6f) * mul;
                    const float inv = 1.0f / ((ps[0] + ps[1]) + (ps[2] + ps[3]));
                    bf16_t* rowp = o0 + (size_t)(r0 + ai * 128 + m * 16) * 1024 + u.pn * 256 + cw;
#pragma unroll
                    for (int bj = 0; bj < 2; ++bj) { f32x4 v0, v1;
#pragma unroll
                        for (int j = 0; j < 4; ++j) { v0[j] = __builtin_amdgcn_exp2f(acc[ai][bj][m][0][j] * r_) * inv; v1[j] = __builtin_amdgcn_exp2f(acc[ai][bj][m][1][j] * r_) * inv; }
                        *(u32x4*)(rowp + bj * 128) = pack8(v0, v1); } }
        } else if (mode == M_STORE_N) {
#pragma unroll
            for (int ai = 0; ai < 2; ++ai)
#pragma unroll
                for (int m = 0; m < 4; ++m) { bf16_t* rowp = o0 + ((size_t)(u.pm >> 2) * 1024 + u.pn * 256 + ai * 128 + wr * 64 + m * 16 + fr) * 1024 + (u.pm & 3) * 256 + cw;
#pragma unroll
                    for (int bj = 0; bj < 2; ++bj) *(u32x4*)(rowp + bj * 128) = pack8(acc[ai][bj][m][0], acc[ai][bj][m][1]); }
        } else if (mode == M_G) {
#pragma unroll
            for (int ai = 0; ai < 2; ++ai)
#pragma unroll
                for (int m = 0; m < 4; ++m) { float* p = f2 + (size_t)(r0 + ai * 128 + m * 16) * 128 + cw;
                    *(f32x4*)p = acc[ai][0][m][0]; *(f32x4*)(p + 4) = acc[ai][0][m][1]; }
        } else {
            const int b = u.pm >> 6, g = u.pm & 63, ho0 = (fq & 1) * 8;
            const f32x4 d0 = *(const f32x4*)(f1 + g * 16 + ho0), d1 = *(const f32x4*)(f1 + g * 16 + ho0 + 4);
            const bf16_t* const ub = b0 + ((size_t)u.pm * 256 + wr * 64 + fr) * 384 + (wc * 2 + (fq >> 1)) * 16 + ho0;
            bf16_t* const yb = o0 + ((size_t)b * 4096 + (wr * 64 + fr) * 16 + wc * 2 + (fq >> 1)) * 1024 + g * 16 + ho0;
#pragma unroll
            for (int ai = 0; ai < 2; ++ai) { u32x4 uw[4][2];
#pragma unroll
                for (int m = 0; m < 4; ++m)
#pragma unroll
                    for (int bj = 0; bj < 2; ++bj) uw[m][bj] = *(const u32x4*)(ub + (size_t)(ai * 128 + m * 16) * 384 + bj * 128);
                asm volatile("" ::: "memory");
#pragma unroll
                for (int m = 0; m < 4; ++m)
#pragma unroll
                    for (int bj = 0; bj < 2; ++bj) { const u32x4 w = uw[m][bj];
                        f32x4 v0 = acc[ai][bj][m][0], v1 = acc[ai][bj][m][1];
                        v0[0] += d0[0] * bf_lo(w.x); v0[1] += d0[1] * bf_hi(w.x); v0[2] += d0[2] * bf_lo(w.y); v0[3] += d0[3] * bf_hi(w.y);
                        v1[0] += d1[0] * bf_lo(w.z); v1[1] += d1[1] * bf_hi(w.z); v1[2] += d1[2] * bf_lo(w.w); v1[3] += d1[3] * bf_hi(w.w);
#pragma unroll
                        for (int j = 0; j < 4; ++j) { v0[j] = gelu_tanh(v0[j]); v1[j] = gelu_tanh(v1[j]); }
                        *(u32x4*)(yb + (size_t)(ai * 128 + m * 16) * 16384 + bj * 8192) = pack8(v0, v1); } }
        }
    }
};

template <class Epi, class Sched, bool ALIGN_EPI = false, bool SP2 = false>
__device__ __forceinline__ void gemm_phase(PG8_LAS unsigned char* lds, const int lda, const int ldb, const int K, const Sched& S, const Epi& E, const int tid) {
    const int wid = __builtin_amdgcn_readfirstlane(tid >> 6), lane = tid & 63, wr = wid >> 2, wc = wid & 3, fr = lane & 15, fq = lane >> 4;
    const int nt = K / BK;
    unsigned voffA[2], voffB[2];
#pragma unroll
    for (int i = 0; i < 2; ++i) { int R, C; stage_rc(tid * 16 + i * 8192, R, C); const int Rb = Epi::PERM ? ((R & ~31) + perm32(R & 31)) : R;
        voffA[i] = (unsigned)(R * lda + C) * 2u; voffB[i] = (unsigned)(Rb * ldb + C) * 2u; }
    const size_t kstep = (size_t)(BK * 2);
    const size_t hstepA = (size_t)HALF * lda * 2, hstepB = (size_t)HALF * ldb * 2;
    const unsigned ldsw = (unsigned)wid * 1024u;
    const int aoff = lds_byte(wr * 64 + fr, fq * 8), boff = lds_byte(wc * 32 + fr, fq * 8);
#define PG8_SA(b, h) (((b) * 2 + (h)) * HTB)
#define PG8_SB(b, h) ((4 + (b) * 2 + (h)) * HTB)
#define PG8_STAGE(bufoff, gbase, voff) do { _Pragma("unroll") for (int _i = 0; _i < 2; ++_i) \
        __builtin_amdgcn_global_load_lds((const unsigned*)((const char*)(gbase) + (voff)[_i]), (PG8_LAS unsigned*)(lds + (bufoff) + ldsw + _i * 8192), 16, 0, 0); } while (0)
#define PG8_LDA(dst, b, h) do { _Pragma("unroll") for (int m = 0; m < 4; ++m) _Pragma("unroll") for (int k = 0; k < 2; ++k) dst[m][k] = *(const PG8_LAS bf16x8*)(lds + PG8_SA(b, h) + aoff + m * 2048 + k * 1024); } while (0)
#define PG8_LDB(dst, b, h) do { _Pragma("unroll") for (int n = 0; n < 2; ++n) _Pragma("unroll") for (int k = 0; k < 2; ++k) dst[n][k] = *(const PG8_LAS bf16x8*)(lds + PG8_SB(b, h) + boff + n * 2048 + k * 1024); } while (0)
#define PG8_MMA(ai, bj, At, Bt) do { __builtin_amdgcn_s_setprio(1); _Pragma("unroll") for (int m = 0; m < 4; ++m) _Pragma("unroll") for (int n = 0; n < 2; ++n) _Pragma("unroll") for (int k = 0; k < 2; ++k) \
        acc[ai][bj][m][n] = __builtin_amdgcn_mfma_f32_16x16x32_bf16(Bt[n][k], At[m][k], acc[ai][bj][m][n], 0, 0, 0); __builtin_amdgcn_s_setprio(0); } while (0)
#define PG8_WAIT_V(n) asm volatile("s_waitcnt vmcnt(" #n ")" ::: "memory")
#define PG8_WAIT_L(n) asm volatile("s_waitcnt lgkmcnt(" #n ")" ::: "memory")
#define PG8_BAR __builtin_amdgcn_s_barrier()
#define PG8_SCHED __builtin_amdgcn_sched_barrier(0)
    Unit cur, nxt; int ui = 0;
    if (!S.next(0, cur)) return;
    f32x4 acc[2][2][4][2];
#pragma unroll
    for (int a = 0; a < 2; ++a)
#pragma unroll
        for (int b = 0; b < 2; ++b)
#pragma unroll
            for (int m = 0; m < 4; ++m)
#pragma unroll
                for (int n = 0; n < 2; ++n) acc[a][b][m][n] = (f32x4){0.f, 0.f, 0.f, 0.f};
    bf16x8 At[4][2], B0[2][2], B1[2][2];
    const char* cA = S.abase(cur); const char* cB = S.bbase(cur);
    if constexpr (SP2) {
        PG8_STAGE(PG8_SB(0, 0), cB, voffB); PG8_STAGE(PG8_SB(0, 1), cB + hstepB, voffB); PG8_STAGE(PG8_SA(0, 0), cA, voffA); PG8_STAGE(PG8_SA(0, 1), cA + hstepA, voffA);
        if (wr == 1) PG8_BAR;
        PG8_WAIT_V(2); PG8_BAR;
        PG8_STAGE(PG8_SB(1, 0), cB + kstep, voffB); PG8_STAGE(PG8_SA(1, 0), cA + kstep, voffA); PG8_STAGE(PG8_SB(1, 1), cB + hstepB + kstep, voffB);
        PG8_WAIT_V(6); PG8_BAR;
    } else {
        PG8_STAGE(PG8_SB(0, 0), cB, voffB); PG8_STAGE(PG8_SA(0, 0), cA, voffA); PG8_STAGE(PG8_SB(0, 1), cB + hstepB, voffB); PG8_STAGE(PG8_SA(0, 1), cA + hstepA, voffA);
        if (wr == 1) PG8_BAR;
        PG8_WAIT_V(4); PG8_BAR;
        PG8_STAGE(PG8_SB(1, 0), cB + kstep, voffB); PG8_STAGE(PG8_SA(1, 0), cA + kstep, voffA); PG8_STAGE(PG8_SB(1, 1), cB + hstepB + kstep, voffB);
        PG8_WAIT_V(6); PG8_BAR;
    }
    for (;;) {
        const bool has_next = S.next(ui + 1, nxt);
        const char* nA = has_next ? S.abase(nxt) : cA; const char* nB = has_next ? S.bbase(nxt) : cB;
        for (int t = 0; t < nt; t += 2) {
            const bool last = (t == nt - 2);
            const char* a1 = cA + (size_t)(t + 1) * kstep;
            const char* a2 = last ? nA : cA + (size_t)(t + 2) * kstep; const char* b2 = last ? nB : cB + (size_t)(t + 2) * kstep;
            const char* a3 = a2 + kstep; const char* b3 = b2 + kstep;
            if constexpr (SP2) {
            PG8_LDB(B0, 0, 0); PG8_LDB(B1, 0, 1); PG8_SCHED; PG8_LDA(At, 0, 0); PG8_STAGE(PG8_SA(1, 1), a1 + hstepA, voffA);
            PG8_WAIT_V(8); PG8_WAIT_L(0); PG8_BAR; PG8_MMA(0, 0, At, B0); PG8_MMA(0, 1, At, B1); PG8_BAR; PG8_SCHED;
            PG8_LDA(At, 0, 1); PG8_STAGE(PG8_SB(0, 0), b2, voffB); PG8_STAGE(PG8_SB(0, 1), b2 + hstepB, voffB); PG8_STAGE(PG8_SA(0, 0), a2, voffA);
            PG8_WAIT_V(8); PG8_WAIT_L(0); PG8_BAR; PG8_MMA(1, 0, At, B0); PG8_MMA(1, 1, At, B1); PG8_BAR; PG8_SCHED;
            PG8_LDB(B0, 1, 0); PG8_LDB(B1, 1, 1); PG8_SCHED; PG8_LDA(At, 1, 0); PG8_STAGE(PG8_SA(0, 1), a2 + hstepA, voffA);
            PG8_WAIT_V(8); PG8_WAIT_L(0); PG8_BAR; PG8_MMA(0, 0, At, B0); PG8_MMA(0, 1, At, B1); PG8_BAR; PG8_SCHED;
            PG8_LDA(At, 1, 1); PG8_STAGE(PG8_SB(1, 0), b3, voffB); PG8_STAGE(PG8_SB(1, 1), b3 + hstepB, voffB); PG8_STAGE(PG8_SA(1, 0), a3, voffA);
            PG8_WAIT_V(8); PG8_WAIT_L(0); PG8_BAR; PG8_MMA(1, 0, At, B0); PG8_MMA(1, 1, At, B1); PG8_BAR; PG8_SCHED;
            } else {
            PG8_LDB(B0, 0, 0); PG8_SCHED; PG8_LDA(At, 0, 0); PG8_STAGE(PG8_SA(1, 1), a1 + hstepA, voffA);
            PG8_WAIT_L(8); PG8_BAR; PG8_WAIT_L(0); PG8_MMA(0, 0, At, B0); PG8_BAR; PG8_SCHED;
            PG8_LDB(B1, 0, 1); PG8_STAGE(PG8_SB(0, 0), b2, voffB);
            PG8_BAR; PG8_WAIT_L(0); PG8_MMA(0, 1, At, B1); PG8_BAR;
            PG8_LDA(At, 0, 1); PG8_STAGE(PG8_SA(0, 0), a2, voffA);
            PG8_BAR; PG8_WAIT_L(0); PG8_MMA(1, 0, At, B0); PG8_BAR; PG8_SCHED;
            PG8_STAGE(PG8_SB(0, 1), b2 + hstepB, voffB);
            PG8_WAIT_V(6); PG8_BAR; PG8_MMA(1, 1, At, B1); PG8_BAR;
            PG8_LDB(B0, 1, 0); PG8_SCHED; PG8_LDA(At, 1, 0); PG8_STAGE(PG8_SA(0, 1), a2 + hstepA, voffA);
            PG8_WAIT_L(8); PG8_BAR; PG8_WAIT_L(0); PG8_MMA(0, 0, At, B0); PG8_BAR; PG8_SCHED;
            PG8_LDB(B1, 1, 1); PG8_STAGE(PG8_SB(1, 0), b3, voffB);
            PG8_BAR; PG8_WAIT_L(0); PG8_MMA(0, 1, At, B1); PG8_BAR;
            PG8_LDA(At, 1, 1); PG8_STAGE(PG8_SA(1, 0), a3, voffA);
            PG8_BAR; PG8_WAIT_L(0); PG8_MMA(1, 0, At, B0); PG8_BAR; PG8_SCHED;
            PG8_STAGE(PG8_SB(1, 1), b3 + hstepB, voffB);
            PG8_WAIT_V(6); PG8_BAR; PG8_MMA(1, 1, At, B1); PG8_BAR;
            }
        }
        if constexpr (ALIGN_EPI) { if (wr == 0) PG8_BAR; }
        { int frv = fr, fqv = fq; asm volatile("" : "+v"(frv), "+v"(fqv)); E(acc, cur, wr, wc, frv, fqv, lds + 131072 + 1024); }
        if (!has_next) break;
#pragma unroll
        for (int a = 0; a < 2; ++a)
#pragma unroll
            for (int b = 0; b < 2; ++b)
#pragma unroll
                for (int m = 0; m < 4; ++m)
#pragma unroll
                    for (int n = 0; n < 2; ++n) acc[a][b][m][n] = (f32x4){0.f, 0.f, 0.f, 0.f};
        cur = nxt; cA = nA; cB = nB; ++ui;
        if constexpr (ALIGN_EPI) { if (wr == 1) PG8_BAR; }
    }
    PG8_WAIT_V(0);
    if constexpr (!ALIGN_EPI) { if (wr == 0) PG8_BAR; }
    PG8_BAR;
#undef PG8_SA
#undef PG8_SB
#undef PG8_STAGE
#undef PG8_LDA
#undef PG8_LDB
#undef PG8_MMA
#undef PG8_WAIT_V
#undef PG8_WAIT_L
#undef PG8_BAR
#undef PG8_SCHED
}
}
using pg8::bf16_t; using pg8::f32x4; using pg8::u32x4; using pg8::u32x2;
#define LAS __attribute__((address_space(3)))

constexpr int BATCH = 8, SEQ = 4096, D = 1024, T = BATCH * SEQ, DEPTH = 4, NMEM = 256, HEADS = 4, HD = 256, FF = 4096;
constexpr int SG = 64, SP = 64, SH = 16, CL = 16, NCH = SEQ / CL;
constexpr int KX = CL * SH + 2 * SP;
constexpr float EPS = 1e-6f;
constexpr int NWAVES = 8, NTHR = 512;
constexpr int LDS_BYTES = 147456;

constexpr size_t MiB = 1u << 20;
constexpr size_t WS_SS = 0;
constexpr size_t WS_L = 4 * MiB;
constexpr size_t WS_ZERO_BYTES = 8 * MiB;
constexpr size_t WS_TAB = 8 * MiB;
constexpr size_t WS_F = 9 * MiB;
constexpr size_t WS_W2X = 14 * MiB;
constexpr size_t WS_MEMN = 26 * MiB;
constexpr size_t WS_KB = 30 * MiB;
constexpr size_t WS_VT = 46 * MiB;
constexpr size_t WS_WGLU = 62 * MiB, WS_WIN = 70 * MiB, WS_WOUT = 82 * MiB, WS_WQ = 86 * MiB, WS_WK = 94 * MiB, WS_WV = 102 * MiB, WS_WO = 110 * MiB, WS_W1 = 118 * MiB, WS_W2 = 150 * MiB;
constexpr size_t WS_XG = 182 * MiB;
constexpr size_t WS_BIG = 246 * MiB;
constexpr size_t WS_BAR = 502 * MiB;
constexpr size_t WS_END = 503 * MiB;
constexpr size_t BG_H = 0, BG_P = 0, BG_MB = 64 * MiB, BG_NB = 80 * MiB, BG_BC = 0, BG_Z = 64 * MiB, BG_UC = 128 * MiB, BG_UEXT = 0, BG_G = 96 * MiB, BG_Y = 160 * MiB;

struct Args { const float* in[24]; float* out; unsigned char* ws; };

__device__ __forceinline__ float wave_sum(float v) {
#pragma unroll
    for (int o = 1; o < 64; o <<= 1) v += __shfl_xor(v, o);
    return v;
}
__device__ __forceinline__ unsigned f2bf(float f) { unsigned u = __float_as_uint(f); return (u + 0x7fffu + ((u >> 16) & 1u)) >> 16; }
__device__ __forceinline__ unsigned pk2(float lo, float hi) { return f2bf(lo) | (f2bf(hi) << 16); }

__device__ __forceinline__ void transpose_item(const float* W, int K, int N, bf16_t* drow0, int k0, int n0, const float* gain, LAS float* scr, int lane) {
    const float gl = gain ? gain[k0 + lane] : 1.0f;
    float wv[32];
    const float* wp = W + (size_t)(k0 + (lane >> 5)) * N + n0 + (lane & 31);
#pragma unroll
    for (int i = 0; i < 32; ++i) wv[i] = __builtin_nontemporal_load(wp + (size_t)(2 * i) * N);
    asm volatile("" ::: "memory");
#pragma unroll
    for (int i = 0; i < 32; ++i) { const int kk = 2 * i + (lane >> 5); scr[kk * 33 + (lane & 31)] = wv[i] * __shfl(gl, kk); }
    asm volatile("s_waitcnt lgkmcnt(0)" ::: "memory");
    const int c = lane & 7;
#pragma unroll
    for (int j = 0; j < 4; ++j) { const int n = (lane >> 3) + 8 * j; const LAS float* s = scr + (8 * c) * 33 + n;
        u32x4 o; o.x = pk2(s[0 * 33], s[1 * 33]); o.y = pk2(s[2 * 33], s[3 * 33]); o.z = pk2(s[4 * 33], s[5 * 33]); o.w = pk2(s[6 * 33], s[7 * 33]);
        *(u32x4*)(drow0 + (size_t)n * K + k0 + 8 * c) = o; }
    asm volatile("s_waitcnt lgkmcnt(0)" ::: "memory");
}

__device__ __forceinline__ void rms_row(const float* xrow, const float* gain, int lane, f32x4 (&v)[4]) {
    const f32x4* xr = (const f32x4*)xrow + lane; const f32x4* gr = (const f32x4*)gain + lane; float s = 0.f;
#pragma unroll
    for (int j = 0; j < 4; ++j) { v[j] = xr[64 * j]; s += (v[j][0] * v[j][0] + v[j][1] * v[j][1]) + (v[j][2] * v[j][2] + v[j][3] * v[j][3]); }
    const float rstd = 1.0f / sqrtf(wave_sum(s) * (1.0f / D) + EPS);
#pragma unroll
    for (int j = 0; j < 4; ++j) v[j] = v[j] * rstd * gr[64 * j];
}

__device__ __forceinline__ void rms_row_bf(const bf16_t* xrow, const float* gain, int lane, f32x4 (&v)[4]) {
    const u32x2* xr = (const u32x2*)xrow + lane; const f32x4* gr = (const f32x4*)gain + lane; float s = 0.f;
#pragma unroll
    for (int j = 0; j < 4; ++j) { const u32x2 w = xr[64 * j]; v[j] = (f32x4){pg8::bf_lo(w.x), pg8::bf_hi(w.x), pg8::bf_lo(w.y), pg8::bf_hi(w.y)}; s += (v[j][0] * v[j][0] + v[j][1] * v[j][1]) + (v[j][2] * v[j][2] + v[j][3] * v[j][3]); }
    const float rstd = 1.0f / sqrtf(wave_sum(s) * (1.0f / D) + EPS);
#pragma unroll
    for (int j = 0; j < 4; ++j) v[j] = v[j] * rstd * gr[64 * j];
}

template <bool BF> __device__ __forceinline__ void norm_chunk_to_uext(const void* x, const float* gain, bf16_t* uext, int ci, LAS unsigned char* lds, int wave, int lane) {
    const int b = ci >> 8, c = ci & 255; const size_t t0 = (size_t)b * SEQ + c * CL;
    constexpr int PITCH = 2064;
    f32x4 vv[2][4];
#pragma unroll
    for (int r = 0; r < 2; ++r) { const int tok = r * 8 + wave;
        if (BF) { const u32x2* xr = (const u32x2*)((const bf16_t*)x + (t0 + tok) * D) + lane;
#pragma unroll
            for (int j = 0; j < 4; ++j) { const u32x2 w = xr[64 * j]; vv[r][j] = (f32x4){pg8::bf_lo(w.x), pg8::bf_hi(w.x), pg8::bf_lo(w.y), pg8::bf_hi(w.y)}; } }
        else { const f32x4* xr = (const f32x4*)((const float*)x + (t0 + tok) * D) + lane;
#pragma unroll
            for (int j = 0; j < 4; ++j) vv[r][j] = xr[64 * j]; } }
#pragma unroll
    for (int r = 0; r < 2; ++r) { const int tok = r * 8 + wave; float ss = 0.f; const f32x4* gr = (const f32x4*)gain + lane;
#pragma unroll
        for (int j = 0; j < 4; ++j) ss += (vv[r][j][0] * vv[r][j][0] + vv[r][j][1] * vv[r][j][1]) + (vv[r][j][2] * vv[r][j][2] + vv[r][j][3] * vv[r][j][3]);
        const float rstd = 1.0f / sqrtf(wave_sum(ss) * (1.0f / D) + EPS);
#pragma unroll
        for (int j = 0; j < 4; ++j) { const f32x4 v = vv[r][j] * rstd * gr[64 * j]; u32x2 w; w.x = pk2(v[0], v[1]); w.y = pk2(v[2], v[3]); *(LAS u32x2*)(lds + tok * PITCH + (4 * lane + 256 * j) * 2) = w; } }
    __syncthreads();
    const int l32 = lane & 31, tk = l32 >> 1, half = l32 & 1;
#pragma unroll
    for (int gi = 0; gi < 8; gi += 2) { const int g = wave * 8 + gi + (lane >> 5);
        const u32x4 w = *(const LAS u32x4*)(lds + tk * PITCH + (g * 16 + half * 8) * 2);
        *(u32x4*)(uext + ((size_t)(b * 64 + g) * 256 + c) * KX + tk * 16 + half * 8) = w; }
    __syncthreads();
}

struct SsmIn { const float *a_re, *a_im, *log_dt, *b_re, *b_im, *c_re, *c_im; unsigned char* ws; };
__device__ __forceinline__ void build_ssm(const SsmIn& a, int j, int g, LAS unsigned char* lds, int tid) {
    typedef float f32x2 __attribute__((ext_vector_type(2)));
    LAS f32x2* pw = (LAS f32x2*)lds;
    LAS f32x2* bb = (LAS f32x2*)(lds + 8704);
    LAS f32x2* cc = (LAS f32x2*)(lds + 16896);
    LAS float* kk = (LAS float*)(lds + 25088);
    const float* a_re = a.a_re + (size_t)(j * SG + g) * SP; const float* a_im = a.a_im + (size_t)(j * SG + g) * SP;
    const float dt = expf(a.log_dt[j * SG + g]);
    const float* b_re = a.b_re + (size_t)(j * SG + g) * SP * SH; const float* b_im = a.b_im + (size_t)(j * SG + g) * SP * SH;
    const float* c_re = a.c_re + (size_t)(j * SG + g) * SH * SP; const float* c_im = a.c_im + (size_t)(j * SG + g) * SH * SP;
    if (tid < 64) { const float are = a_re[tid], aim = a_im[tid];
        for (int k = 0; k <= 16; ++k) { const float mag = expf(are * dt * (float)k); double ang = (double)aim * (double)dt * (double)k; ang -= 6.283185307179586 * rint(ang * 0.15915494309189535);
            float sn, cs; sincosf((float)ang, &sn, &cs); pw[k * 64 + tid] = (f32x2){mag * cs, mag * sn}; }
        const float mag = expf(are * dt * 1024.0f); double ang = (double)aim * (double)dt * 1024.0; ang -= 6.283185307179586 * rint(ang * 0.15915494309189535);
        float sn, cs; sincosf((float)ang, &sn, &cs);
        f32x4 t; t[0] = pw[16 * 64 + tid].x; t[1] = pw[16 * 64 + tid].y; t[2] = mag * cs; t[3] = mag * sn;
        *(f32x4*)(a.ws + WS_TAB + ((size_t)g * 64 + tid) * 16) = t; }
    __syncthreads();
    for (int idx = tid; idx < 1024; idx += NTHR) { const int p = idx >> 4;
        const float are = a_re[p], aim = a_im[p]; const f32x2 ab = pw[64 + p];
        const float nr = ab.x - 1.0f, ni = ab.y, den = 1.0f / (are * are + aim * aim);
        const float qr = (nr * are + ni * aim) * den, qi = (ni * are - nr * aim) * den;
        const float br = b_re[idx], bi = b_im[idx];
        bb[idx] = (f32x2){qr * br - qi * bi, qr * bi + qi * br};
        cc[idx] = (f32x2){c_re[idx], c_im[idx]}; }
    __syncthreads();
    for (int idx = tid; idx < 4096; idx += NTHR) { const int k = idx >> 8, ho = (idx >> 4) & 15, hi = idx & 15; float s = 0.f;
        for (int p = 0; p < 64; ++p) { const f32x2 c = cc[ho * 64 + p], w = pw[k * 64 + p], bq = bb[p * 16 + hi];
            const float tr = c.x * w.x - c.y * w.y, ti = c.x * w.y + c.y * w.x; s += tr * bq.x - ti * bq.y; }
        kk[idx] = s; }
    __syncthreads();
    unsigned* w2 = (unsigned*)(a.ws + WS_W2X) + (size_t)g * 256 * (KX / 2);
    for (int idx = tid; idx < 256 * (KX / 2); idx += NTHR) { const int n = idx / (KX / 2), kc = (idx % (KX / 2)) * 2, jt = n >> 4, ho = n & 15; float v0, v1;
        if (kc < 256) { const int i = kc >> 4, hi = kc & 15; if (i <= jt) { v0 = kk[((jt - i) * 16 + ho) * 16 + hi]; v1 = kk[((jt - i) * 16 + ho) * 16 + hi + 1]; } else { v0 = 0.f; v1 = 0.f; } }
        else { const int p = (kc - 256) & 63; const f32x2 c0 = cc[ho * 64 + p], c1 = cc[ho * 64 + p + 1], w0 = pw[(jt + 1) * 64 + p], w1 = pw[(jt + 1) * 64 + p + 1];
            if (kc < 320) { v0 = c0.x * w0.x - c0.y * w0.y; v1 = c1.x * w1.x - c1.y * w1.y; } else { v0 = -(c0.x * w0.y + c0.y * w0.x); v1 = -(c1.x * w1.y + c1.y * w1.x); } }
        w2[idx] = pk2(v0, v1); }
    unsigned* fm = (unsigned*)(a.ws + WS_F) + (size_t)g * 128 * 128;
    for (int idx = tid; idx < 128 * 128; idx += NTHR) { const int n = idx >> 7, kc = (idx & 127) * 2, p = n & 63, i = kc >> 4, hi = kc & 15;
        const f32x2 w = pw[(15 - i) * 64 + p], q0 = bb[p * 16 + hi], q1 = bb[p * 16 + hi + 1]; float v0, v1;
        if (n < 64) { v0 = w.x * q0.x - w.y * q0.y; v1 = w.x * q1.x - w.y * q1.y; } else { v0 = w.x * q0.y + w.y * q0.x; v1 = w.x * q1.y + w.y * q1.x; }
        fm[idx] = pk2(v0, v1); }
    __syncthreads();
}

__device__ __forceinline__ void ssm_scan(unsigned char* ws_, LAS unsigned char* lds, const pg8::Order& S, int wave, int lane) {
    struct { unsigned char* ws; } a; a.ws = ws_;
    typedef float f32x2 __attribute__((ext_vector_type(2)));
    LAS f32x2* ex = (LAS f32x2*)lds;
    const float* Gb = (const float*)(a.ws + WS_BIG + BG_G); bf16_t* ue = (bf16_t*)(a.ws + WS_BIG + BG_UEXT);
    for (int i = 0; ; i += 2) {
        pg8::Unit u0, u1; if (!S.next(i, u0)) break; const bool has1 = S.next(i + 1, u1);
        const int bg = (wave >> 2) ? (has1 ? u1.pm : u0.pm) : u0.pm, seg = wave & 3, g = bg & 63, p = lane; const bool live = (wave >> 2) == 0 || has1;
        const f32x4 tb = *(const f32x4*)(a.ws + WS_TAB + ((size_t)g * 64 + p) * 16);
        const float* gp = Gb + ((size_t)bg * 256 + seg * 64) * 128 + p;
        float er = 0.f, ei = 0.f;
        for (int c0 = 0; c0 < 64; c0 += 16) { float gr[16], gi[16];
#pragma unroll
            for (int k = 0; k < 16; ++k) { gr[k] = gp[(size_t)(c0 + k) * 128]; gi[k] = gp[(size_t)(c0 + k) * 128 + 64]; }
#pragma unroll
            for (int k = 0; k < 16; ++k) { const float nr = tb[0] * er - tb[1] * ei + gr[k], ni = tb[0] * ei + tb[1] * er + gi[k]; er = nr; ei = ni; } }
        ex[wave * 64 + p] = (f32x2){er, ei};
        __syncthreads();
        float sr = 0.f, si = 0.f;
        for (int s = 0; s < seg; ++s) { const f32x2 e = ex[((wave & 4) + s) * 64 + p]; const float nr = tb[2] * sr - tb[3] * si + e.x, ni = tb[2] * si + tb[3] * sr + e.y; sr = nr; si = ni; }
        bf16_t* up = ue + ((size_t)bg * 256 + seg * 64) * KX + 256 + p;
        for (int c0 = 0; c0 < 64; c0 += 16) { float gr[16], gi[16];
#pragma unroll
            for (int k = 0; k < 16; ++k) { gr[k] = gp[(size_t)(c0 + k) * 128]; gi[k] = gp[(size_t)(c0 + k) * 128 + 64]; }
#pragma unroll
            for (int k = 0; k < 16; ++k) { if (live) { up[(size_t)(c0 + k) * KX] = (bf16_t)f2bf(sr); up[(size_t)(c0 + k) * KX + 64] = (bf16_t)f2bf(si); }
                const float nr = tb[0] * sr - tb[1] * si + gr[k], ni = tb[0] * si + tb[1] * sr + gi[k]; sr = nr; si = ni; } }
        __syncthreads();
    }
}

#define XB_TMO      128
#define XB_XCNT(j)  (256  + 64 * (j))
#define XB_XSUB(j)  (1280 + 64 * (j))
#define XB_XGEN(j)  (2304 + 64 * (j))
#define XB_TOP      3328
#define XB_TOPGEN   3392
#define XCD_BAR_WORDS 3456
#define XB_SPIN_CAP (1u << 22)
__device__ __forceinline__ unsigned xb_ld(unsigned* p)              { return __hip_atomic_load(p, __ATOMIC_RELAXED, __HIP_MEMORY_SCOPE_AGENT); }
__device__ __forceinline__ unsigned xb_add(unsigned* p, unsigned v) { return __hip_atomic_fetch_add(p, v, __ATOMIC_RELAXED, __HIP_MEMORY_SCOPE_AGENT); }
__device__ __forceinline__ unsigned xb_xcc_id() { return (unsigned)__builtin_amdgcn_s_getreg((3 << 11) | 20) & 0xFu; }
#define XB_SPIN(cond, bar) do { unsigned _sp = 0; while (cond) { __builtin_amdgcn_s_sleep(1); \
    if ((++_sp & 255u) == 0u) { if (xb_ld(&(bar)[XB_TMO])) break; if (_sp > XB_SPIN_CAP) { atomicAdd(&(bar)[XB_TMO], 1u); break; } } } } while (0)
struct XcdBarrier { unsigned* bar; unsigned x; volatile LAS unsigned* st; };
__device__ __forceinline__ XcdBarrier xcd_barrier_post(unsigned* bar, volatile LAS unsigned* st) {
    XcdBarrier b; b.bar = bar; b.x = xb_xcc_id(); b.st = st;
    if (threadIdx.x == 0) (void)xb_add(&bar[XB_XCNT(b.x)], 1u);
    return b;
}
__device__ __forceinline__ void xcd_barrier_complete(unsigned* bar, unsigned x, unsigned& nloc, unsigned& nx) {
    const unsigned G = gridDim.x * gridDim.y * gridDim.z;
    unsigned sum, cnt, mine, sp = 0u;
    for (;;) {
        sum = 0u; cnt = 0u; mine = 0u;
#pragma unroll
        for (unsigned j = 0; j < 16; ++j) { const unsigned c = xb_ld(&bar[XB_XCNT(j)]); sum += c; cnt += (c > 0u) ? 1u : 0u; mine = (j == x) ? c : mine; }
        if (sum == G) break;
        __builtin_amdgcn_s_sleep(1);
        if ((++sp & 255u) == 0u) { if (xb_ld(&bar[XB_TMO])) break; if (sp > XB_SPIN_CAP) { atomicAdd(&bar[XB_TMO], 1u); break; } }
    }
    nloc = mine > 0u ? mine : 1u; nx = cnt > 0u ? cnt : 1u;
}
__device__ __forceinline__ void xcd_barrier(const XcdBarrier& b) {
    asm volatile("s_waitcnt vmcnt(0)" ::: "memory");
    __syncthreads();
    if (threadIdx.x == 0) {
        unsigned* bar = b.bar;
        __builtin_amdgcn_s_waitcnt(0);
        unsigned nloc = b.st[0], nx = b.st[1];
        if (nloc == 0u) { xcd_barrier_complete(bar, b.x, nloc, nx); b.st[0] = nloc; b.st[1] = nx; }
        const unsigned old = xb_add(&bar[XB_XSUB(b.x)], 1u);
        const unsigned gen = old / nloc;
        if (old + 1u == (gen + 1u) * nloc) {
            __builtin_amdgcn_fence(__ATOMIC_RELEASE, "agent");
            asm volatile("s_waitcnt vmcnt(0)" ::: "memory");
            const unsigned og = xb_add(&bar[XB_TOP], 1u);
            const unsigned tg = og / nx;
            if (og + 1u == (tg + 1u) * nx) xb_add(&bar[XB_TOPGEN], 1u);
            else XB_SPIN(xb_ld(&bar[XB_TOPGEN]) == tg, bar);
            __builtin_amdgcn_fence(__ATOMIC_ACQUIRE, "agent");
            xb_add(&bar[XB_XGEN(b.x)], 1u);
            asm volatile("s_waitcnt vmcnt(0)" ::: "memory");
        } else {
            XB_SPIN(xb_ld(&bar[XB_XGEN(b.x)]) == gen, bar);
            __builtin_amdgcn_fence(__ATOMIC_ACQUIRE, "agent");
            asm volatile("s_waitcnt vmcnt(0)" ::: "memory");
        }
    }
    __syncthreads();
}

enum { PH_P0 = 0, PH_KVK, PH_KVV, PH_SSM1, PH_SCAN, PH_SSM3, PH_GLU, PH_Q  , PH_SP  , PH_OV  , PH_WO  , PH_UP, PH_DOWN, PH_CONVIN, PH_CONV, PH_CONVOUT, PH_NORM2, PH_FINAL };
constexpr int NPROG = 43;
#ifndef PROBE_REP_MASK
#define PROBE_REP_MASK 0u
#endif
#ifndef PROBE_P0_PARTS
#define PROBE_P0_PARTS 0u
#endif
#ifndef PROBE_SYNC_REP
#define PROBE_SYNC_REP 1
#endif

__global__ void __launch_bounds__(NTHR, 2) mega_fwd(Args a) {
    extern __shared__ __attribute__((aligned(16))) unsigned char lds_raw[];
    cg::grid_group grid = cg::this_grid();
    LAS unsigned char* lds = (LAS unsigned char*)lds_raw;
    const int Gn = gridDim.x, bx = blockIdx.x, wave0 = __builtin_amdgcn_readfirstlane((int)(threadIdx.x >> 6));
    const int vcu = (Gn % 8 == 0) ? (bx % 8) * (Gn / 8) + bx / 8 : bx;
    const int NGW = Gn * NWAVES;
#define AS4 __attribute__((address_space(4)))
    { unsigned char* ws = a.ws;
    if (threadIdx.x < 8) ((LAS unsigned*)(lds + 131072 + 64))[threadIdx.x] = 0u;
    __syncthreads();
    (void)xcd_barrier_post((unsigned*)(ws + WS_BAR), (volatile LAS unsigned*)(lds + 131072 + 64)); }

#pragma nounroll
    for (int pi = 0; pi < NPROG; ++pi) {
        int ph, l = 0;
        if (pi < 3) ph = pi;
        else { int q = pi - 3;
            if (q == 19) ph = PH_NORM2; else if (q == 39) ph = PH_FINAL;
            else { if (q >= 20) { q -= 20; l = 2; } int r = q; if (q >= 10) { r = q - 10; l += 1; }
                if (l & 1) ph = (r < 3) ? PH_CONVIN + r : PH_Q + (r - 3); else ph = (r < 4) ? PH_SSM1 + r : PH_Q + (r - 4); } }
        const int j = l >> 1;
        const AS4 char* kp = (const AS4 char*)__builtin_amdgcn_kernarg_segment_ptr(); asm volatile("" : "+s"(kp));
#define INP(k) (*(const float* const AS4*)(kp + 8 * (k)))
        unsigned char* const ws = *(unsigned char* const AS4*)(kp + 200);
        float* const xres = *(float* const AS4*)(kp + 192);
        bf16_t* const XG = (bf16_t*)(ws + WS_XG);
        unsigned char* const big = ws + WS_BIG;
        int lanev = (int)__builtin_amdgcn_mbcnt_hi(~0u, __builtin_amdgcn_mbcnt_lo(~0u, 0u)); asm volatile("" : "+v"(lanev));
        const int lane = lanev, wave = wave0, tid = wave * 64 + lane, gw = vcu * NWAVES + wave;
        bool is_gemm = true, do_sync = true, local_seam = false;
        pg8::Order S; pg8::Epi E; int lda = D, ldb = D, K = D;
        S.G = Gn; S.c = bx; S.an = 0; S.bb = 0; S.bg = 0; S.ash = 0; S.amask = 0; S.am2 = 0; S.bsh = 4; S.bmask = 63; S.nM = T / 256; S.nN = 4; S.A = nullptr; S.B = nullptr; S.am = 256L * D * 2; S.bn = 256L * D * 2;
        E.mode = pg8::M_STORE; E.ldc = D; E.mul = 1.0f; E.o0 = nullptr; E.o1 = nullptr; E.f0 = nullptr; E.f1 = nullptr; E.f2 = nullptr; E.b0 = nullptr; E.sin = nullptr; E.sout = nullptr;
        unsigned long long* const SSb = (unsigned long long*)(ws + WS_SS); unsigned long long* const Lb = (unsigned long long*)(ws + WS_L) + (size_t)l * T * 4;
        const int nrep_ng = ((PROBE_REP_MASK >> ph) & 1u) ? 2 : 1;
#pragma nounroll
        for (int rpn = 0; rpn < nrep_ng; ++rpn)
        switch (ph) {
        case PH_P0: { is_gemm = false;
            { f32x4* z = (f32x4*)ws; float zf = 0.f; asm volatile("" : "+v"(zf)); const f32x4 zero = {zf, zf, zf, zf}; for (int i = bx * NTHR + tid; i < (int)(WS_ZERO_BYTES / 16); i += Gn * NTHR) z[i] = zero; }
            LAS float* scr = (LAS float*)(lds + wave * 8448);
#pragma nounroll
            for (int rq = 0; rq < ((PROBE_P0_PARTS & 1u) ? 2 : 1); ++rq)
            for (int it = gw; it < 30720; it += NGW) {
                int r = it, idx, K_ = 1024, N_ = 1024, typ; const float* src; const float* gain = nullptr;
                if (r < 2048) { idx = r >> 10; r &= 1023; src = INP(14) + (size_t)idx * 1024 * 2048; N_ = 2048; typ = 0; }
                else if ((r -= 2048) < 3072) { idx = r / 1536; r %= 1536; src = INP(15) + (size_t)idx * 1024 * 3072; N_ = 3072; typ = 1; gain = INP(3) + (size_t)(2 * idx + 1) * D; }
                else if ((r -= 3072) < 1024) { idx = r >> 9; r &= 511; src = INP(17) + (size_t)idx * 1024 * 1024; typ = 2; }
                else if ((r -= 1024) < 2048) { idx = r >> 9; r &= 511; src = INP(18) + (size_t)idx * 1024 * 1024; typ = 3; gain = INP(4) + (size_t)idx * D; }
                else if ((r -= 2048) < 4096) { idx = r >> 10; r &= 1023; src = INP(19) + (size_t)idx * 1024 * 2048; N_ = 2048; typ = 4; }
                else if ((r -= 4096) < 2048) { idx = r >> 9; r &= 511; src = INP(20) + (size_t)idx * 1024 * 1024; typ = 5; }
                else if ((r -= 2048) < 8192) { idx = r >> 11; r &= 2047; src = INP(21) + (size_t)idx * 1024 * 4096; N_ = 4096; typ = 6; gain = INP(5) + (size_t)idx * D; }
                else { r -= 8192; idx = r >> 11; r &= 2047; src = INP(22) + (size_t)idx * 4096 * 1024; K_ = 4096; typ = 7; }
                const int nblk = N_ / 32, kb = r / nblk, nb = r % nblk, k0 = 64 * kb, n0 = 32 * nb; bf16_t* dst;
                switch (typ) {
                case 0: { const int n1 = n0 & 1023, row = (n1 >> 7) * 256 + (n0 >= 1024 ? 128 : 0) + (n1 & 127); dst = (bf16_t*)(ws + WS_WGLU) + ((size_t)idx * 2048 + row) * 1024; } break;
                case 1: { int row; if (n0 < 1024) row = n0; else { const int n1 = (n0 - 1024) & 1023; row = 1024 + (n1 >> 7) * 256 + (n0 >= 2048 ? 128 : 0) + (n1 & 127); } dst = (bf16_t*)(ws + WS_WIN) + ((size_t)idx * 3072 + row) * 1024; } break;
                case 2: dst = (bf16_t*)(ws + WS_WOUT) + ((size_t)idx * 1024 + n0) * 1024; break;
                case 3: dst = (bf16_t*)(ws + WS_WQ) + ((size_t)idx * 1024 + n0) * 1024; break;
                case 4: dst = (n0 < 1024) ? (bf16_t*)(ws + WS_WK) + ((size_t)idx * 1024 + n0) * 1024 : (bf16_t*)(ws + WS_WV) + ((size_t)idx * 1024 + n0 - 1024) * 1024; break;
                case 5: dst = (bf16_t*)(ws + WS_WO) + ((size_t)idx * 1024 + n0) * 1024; break;
                case 6: dst = (bf16_t*)(ws + WS_W1) + ((size_t)idx * 4096 + n0) * 1024; break;
                default: dst = (bf16_t*)(ws + WS_W2) + ((size_t)idx * 1024 + n0) * 4096; break;
                }
                if (typ == 3) {
                    const f32x4* sp = (const f32x4*)(src + (size_t)r * 2048) + lane; u32x2* dp = (u32x2*)((bf16_t*)(ws + WS_WQ) + (size_t)idx * 1024 * 1024 + (size_t)r * 2048) + lane;
                    f32x4 wv[8];
#pragma unroll
                    for (int q = 0; q < 8; ++q) wv[q] = __builtin_nontemporal_load(sp + 64 * q);
                    const float g0 = gain[2 * r], g1 = gain[2 * r + 1];
#pragma unroll
                    for (int q = 0; q < 8; ++q) { const float gq = q < 4 ? g0 : g1; u32x2 w; w.x = pk2(wv[q][0] * gq, wv[q][1] * gq); w.y = pk2(wv[q][2] * gq, wv[q][3] * gq); dp[64 * q] = w; }
                    continue; }
                transpose_item(src, K_, N_, dst, k0, n0, gain, scr, lane);
            }
            for (int m = gw; m < BATCH * NMEM; m += NGW) { f32x4 v[4]; rms_row(INP(1) + (size_t)m * D, INP(2), lane, v); u32x2* o = (u32x2*)((bf16_t*)(ws + WS_MEMN) + (size_t)m * D) + lane;
#pragma unroll
                for (int jj = 0; jj < 4; ++jj) { u32x2 w; w.x = pk2(v[jj][0], v[jj][1]); w.y = pk2(v[jj][2], v[jj][3]); o[64 * jj] = w; } }
            __syncthreads();
#pragma nounroll
            for (int rq = 0; rq < ((PROBE_P0_PARTS & 2u) ? 2 : 1); ++rq)
            for (int ci = bx; ci < BATCH * NCH; ci += Gn) norm_chunk_to_uext<false>(INP(0), INP(3), (bf16_t*)(big + BG_UEXT), ci, lds, wave, lane);
            { SsmIn si{INP(6), INP(7), INP(8), INP(9), INP(10), INP(11), INP(12), ws}; for (int rq = 0; rq < ((PROBE_P0_PARTS & 4u) ? 2 : 1); ++rq) for (int g = bx; g < SG; g += Gn) build_ssm(si, 0, g, lds, tid); }
        } break;
        case PH_KVK: S.nM = BATCH * NMEM / 256; S.nN = 32; S.A = (const char*)(ws + WS_MEMN); S.B = (const char*)(ws + WS_WK); E.o0 = (bf16_t*)(ws + WS_KB); E.ldc = 8192; do_sync = false; break;
        case PH_KVV: is_gemm = false; do_sync = false; break;
        case PH_SSM1: S.nM = BATCH * SG; S.nN = 1; S.A = (const char*)(big + BG_UEXT); S.am = 256L * KX * 2; S.B = (const char*)(ws + WS_F); S.bn = 0; S.bg = 128L * 256 * 2; lda = KX; ldb = 256; K = 256;
            E.mode = pg8::M_G; E.f2 = (float*)(big + BG_G); local_seam = true; break;
        case PH_SCAN: is_gemm = false; local_seam = true; S.nM = BATCH * SG; S.nN = 1; S.nwg = S.nM; ssm_scan(ws, lds, S, wave, lane); break;
        case PH_SSM3: S.nM = BATCH * SG; S.nN = 1; S.A = (const char*)(big + BG_UEXT); S.am = 256L * KX * 2; S.B = (const char*)(ws + WS_W2X); S.bn = 0; S.bg = 256L * KX * 2; lda = KX; ldb = KX; K = KX;
            E.mode = pg8::M_Y; E.o0 = (bf16_t*)(big + BG_Y); E.b0 = (const bf16_t*)(big + BG_UEXT); E.f1 = INP(13) + (size_t)j * D; break;
        case PH_GLU: S.nN = 8; S.A = (const char*)(big + BG_Y); S.B = (const char*)(ws + WS_WGLU + (size_t)j * 2048 * 1024 * 2);
            E.mode = pg8::M_GLU; E.f0 = (l == 0) ? INP(0) : nullptr; E.o0 = XG; E.sout = SSb + (size_t)(l * 3 + 1) * T; do_sync = false; break;
        case PH_Q:
            S.nM = 32; S.nN = 4; S.A = (const char*)(ws + WS_KB + (size_t)l * 1024 * 2); S.ash = 2; S.am = 256L * 8192 * 2; S.amask = 3; S.am2 = 256 * 2;
            S.B = (const char*)(ws + WS_WQ + (size_t)l * 1024 * 1024 * 2); S.bn = 256L * 1024 * 2; S.bmask = 3; S.bg = 256 * 2; lda = 8192; ldb = 1024; K = 256;
            E.o0 = (bf16_t*)(big + BG_MB); E.ldc = 1024; do_sync = false; break;
        case PH_SP:
            S.nM = 32; S.nN = 4; S.c = (bx + Gn / 2) % Gn; S.A = (const char*)(ws + WS_WO + (size_t)l * 1024 * 1024 * 2); S.am = 0; S.amask = 3; S.am2 = 256 * 2; S.an = 256L * 1024 * 2;
            S.B = (const char*)(ws + WS_KB + (size_t)(4096 + l * 1024) * 2); S.bn = 0; S.bsh = 2; S.bb = 256L * 8192 * 2; S.bmask = 3; S.bg = 256 * 2; lda = 1024; ldb = 8192; K = 256;
            E.mode = pg8::M_STORE_N; E.o0 = (bf16_t*)(big + BG_NB); break;
        case PH_OV:
            S.A = (const char*)XG; S.B = (const char*)(big + BG_MB); S.bb = 1024L * 1024 * 2;
            E.mode = pg8::M_SOFT; E.o0 = (bf16_t*)(big + BG_P); E.sin = SSb + (size_t)(l * 3 + 1) * T; E.mul = 0.0625f * 1.4426950409f; break;
        case PH_WO:
            S.A = (const char*)(big + BG_P); S.B = (const char*)(big + BG_NB); S.bb = 1024L * 1024 * 2;
            E.mode = pg8::M_RES; E.o0 = XG; E.sout = SSb + (size_t)(l * 3 + 2) * T; break;
        case PH_UP: S.nN = 16; S.A = (const char*)XG; S.B = (const char*)(ws + WS_W1 + (size_t)l * 4096 * 1024 * 2);
            E.mode = pg8::M_UP; E.o0 = (bf16_t*)(big + BG_H); E.ldc = FF; E.sin = SSb + (size_t)(l * 3 + 2) * T; break;
        case PH_DOWN: S.A = (const char*)(big + BG_H); S.am = 256L * FF * 2; S.B = (const char*)(ws + WS_W2 + (size_t)l * 4096 * 1024 * 2); S.bn = 256L * FF * 2; lda = FF; ldb = FF; K = FF;
            E.mode = pg8::M_RES; E.o0 = XG;
            if ((l & 1) == 0) E.sout = SSb + (size_t)((l + 1) * 3) * T; break;
        case PH_CONVIN: S.nN = 12; S.A = (const char*)XG; S.B = (const char*)(ws + WS_WIN + (size_t)j * 3072 * 1024 * 2);
            E.mode = pg8::M_CONVIN; E.o0 = (bf16_t*)(big + BG_BC); E.o1 = (bf16_t*)(big + BG_Z); E.sin = SSb + (size_t)(l * 3) * T; break;
        case PH_CONV: { is_gemm = false;
            const bf16_t* Bc = (const bf16_t*)(big + BG_BC); const bf16_t* Z = (const bf16_t*)(big + BG_Z); bf16_t* Uc = (bf16_t*)(big + BG_UC); const float* cw = INP(16) + (size_t)j * 3 * D;
            for (int i = bx * NTHR + tid; i < T * 128; i += Gn * NTHR) { const int t = i >> 7, c8 = (i & 127) * 8, tl = t & (SEQ - 1); const size_t off = (size_t)t * D + c8;
                const u32x4 z0 = *(const u32x4*)(Z + off), bv = *(const u32x4*)(Bc + off); unsigned zu = 0u; asm volatile("" : "+v"(zu)); u32x4 z1 = {zu, zu, zu, zu}, z2 = {zu, zu, zu, zu};
                if (tl >= 1) z1 = *(const u32x4*)(Z + off - D); if (tl >= 2) z2 = *(const u32x4*)(Z + off - 2 * D);
                f32x4 o0, o1;
#pragma unroll
                for (int q = 0; q < 4; ++q) { const int cc = c8 + 2 * q;
                    const float w0a = cw[cc], w0b = cw[cc + 1], w1a = cw[D + cc], w1b = cw[D + cc + 1], w2a = cw[2 * D + cc], w2b = cw[2 * D + cc + 1];
                    const float ra = pg8::bf_lo(bv[q]) * (w0a * pg8::bf_lo(z2[q]) + w1a * pg8::bf_lo(z1[q]) + w2a * pg8::bf_lo(z0[q]));
                    const float rb = pg8::bf_hi(bv[q]) * (w0b * pg8::bf_hi(z2[q]) + w1b * pg8::bf_hi(z1[q]) + w2b * pg8::bf_hi(z0[q]));
                    if (q < 2) { o0[2 * q] = ra; o0[2 * q + 1] = rb; } else { o1[2 * (q - 2)] = ra; o1[2 * (q - 2) + 1] = rb; } }
                *(u32x4*)(Uc + off) = pg8::pack8(o0, o1); }
        } break;
        case PH_CONVOUT: S.A = (const char*)(big + BG_UC); S.B = (const char*)(ws + WS_WOUT + (size_t)j * 1024 * 1024 * 2);
            E.mode = pg8::M_RES; E.o0 = XG; E.sout = SSb + (size_t)(l * 3 + 1) * T; do_sync = false; break;
        case PH_NORM2: is_gemm = false;
            for (int ci = bx; ci < BATCH * NCH; ci += Gn) norm_chunk_to_uext<true>(XG, INP(3) + 2 * D, (bf16_t*)(big + BG_UEXT), ci, lds, wave, lane);
            { SsmIn si{INP(6), INP(7), INP(8), INP(9), INP(10), INP(11), INP(12), ws}; for (int g = bx; g < SG; g += Gn) build_ssm(si, 1, g, lds, tid); }
            break;
        default: is_gemm = false;
            for (int m = gw; m < T; m += NGW) { f32x4 v[4]; rms_row_bf(XG + (size_t)m * D, INP(23), lane, v); f32x4* o = (f32x4*)(xres + (size_t)m * D) + lane;
#pragma unroll
                for (int jj = 0; jj < 4; ++jj) o[64 * jj] = v[jj]; }
            do_sync = false; break;
        }
        S.nwg = S.nM * S.nN;
        if (is_gemm) { const int nrep = ((PROBE_REP_MASK >> ph) & 1u) ? 2 : 1;
#pragma nounroll
            for (int rp = 0; rp < nrep; ++rp) pg8::gemm_phase<pg8::Epi, pg8::Order, true, true>(lds, lda, ldb, K, S, E, tid); }
        if (do_sync) {
            if (local_seam) {
                asm volatile("s_waitcnt vmcnt(0)" ::: "memory"); __builtin_amdgcn_fence(__ATOMIC_ACQUIRE, "agent"); asm volatile("s_waitcnt vmcnt(0)" ::: "memory"); __syncthreads();
            } else if (pi == 0) {
                __builtin_amdgcn_fence(__ATOMIC_RELEASE, "agent"); asm volatile("s_waitcnt vmcnt(0)" ::: "memory");
#pragma nounroll
                for (int sr = 0; sr < PROBE_SYNC_REP; ++sr) grid.sync();
                __builtin_amdgcn_fence(__ATOMIC_ACQUIRE, "agent"); asm volatile("s_waitcnt vmcnt(0)" ::: "memory");
            } else {
#pragma nounroll
                for (int sr = 0; sr < PROBE_SYNC_REP; ++sr) { unsigned* barp = (unsigned*)(ws + WS_BAR); XcdBarrier xb; xb.bar = barp; xb.x = xb_xcc_id(); xb.st = (volatile LAS unsigned*)(lds + 131072 + 64); xcd_barrier(xb); }
            }
        }
    }
}

extern "C" void kernel_launch(void* const* d_in, const int* in_sizes, int n_in, void* d_out, int out_size, void* d_ws, size_t ws_size, hipStream_t stream) {
    static int grid = 0;
    if (grid == 0) {
        if (n_in != 24 || out_size != T * D || ws_size < WS_END) { fprintf(stderr, "kernel_launch: unexpected shapes (n_in %d out %d ws %zu)\n", n_in, out_size, ws_size); grid = -1; return; }
        int dev = 0, cus = 0, per_cu = 0;
        (void)hipGetDevice(&dev); (void)hipDeviceGetAttribute(&cus, hipDeviceAttributeMultiprocessorCount, dev);
        if (hipFuncSetAttribute((const void*)mega_fwd, hipFuncAttributeMaxDynamicSharedMemorySize, LDS_BYTES) != hipSuccess) { fprintf(stderr, "kernel_launch: hipFuncSetAttribute failed\n"); grid = -1; return; }
        if (hipOccupancyMaxActiveBlocksPerMultiprocessor(&per_cu, (const void*)mega_fwd, NTHR, LDS_BYTES) != hipSuccess || per_cu < 1) { (void)hipGetLastError(); per_cu = 1; }
        grid = cus * per_cu;
        fprintf(stderr, "kernel_launch: %d CUs x %d blocks/CU\n", cus, per_cu);
    }
    if (grid < 0) return;
    if (hipMemsetAsync((char*)d_ws + WS_BAR, 0, XCD_BAR_WORDS * 4, stream) != hipSuccess) { fprintf(stderr, "kernel_launch: memset failed\n"); return; }
    Args a{};
    for (int i = 0; i < 24; ++i) a.in[i] = (const float*)d_in[i];
    a.out = (float*)d_out; a.ws = (unsigned char*)d_ws;
    void* kargs[] = {&a};
    hipError_t e = hipLaunchCooperativeKernel((const void*)mega_fwd, dim3(grid), dim3(NTHR), kargs, LDS_BYTES, stream);
    if (e != hipSuccess) fprintf(stderr, "kernel_launch: cooperative launch failed: %s (grid %d)\n", hipGetErrorString(e), grid);
}
```

```cpp
#include <hip/hip_runtime.h>
#include <hip/hip_cooperative_groups.h>
#include <cstdio>
#include <cstdint>
namespace cg = cooperative_groups;

namespace pg8 {
#define PG8_LAS __attribute__((address_space(3)))
typedef unsigned short bf16_t;
typedef short bf16x8 __attribute__((ext_vector_type(8)));
typedef float f32x4 __attribute__((ext_vector_type(4)));
typedef unsigned u32x4 __attribute__((ext_vector_type(4)));
typedef unsigned u32x2 __attribute__((ext_vector_type(2)));
constexpr int BM = 256, BK = 64, HALF = 128, HTB = HALF * BK * 2  , STAGE_BYTES = 8 * HTB, NXCD = 8, WGM = 8;

__host__ __device__ __forceinline__ int lds_byte(int r, int c) { const int st = (r >> 4) * 2 + (c >> 5), rr = r & 15, cc = c & 31, ob = rr * 64 + cc * 2; return st * 1024 + (ob ^ (((ob >> 9) & 1) << 5)); }
__host__ __device__ __forceinline__ void stage_rc(int b, int& R, int& C) { const int st = b / 1024, sb = b % 1024, swz = sb ^ (((sb >> 9) & 1) << 5); R = (st >> 1) * 16 + swz / 64; C = (st & 1) * 32 + (swz % 64) / 2; }
__host__ __device__ __forceinline__ int perm32(int rho) { const int n = rho >> 4, i = rho & 15; return 8 * (i >> 2) + 4 * n + (i & 3); }

struct Unit { int pm, pn; };

struct Order {
    int nM, nN, nwg, G, c, ash, amask, bsh, bmask; const char* A; const char* B; long am, am2, an, bn, bb, bg;
    __device__ __forceinline__ bool next(int i, Unit& u) const {
        const long L = (long)i * G + c; if (L >= nwg) return false;
        int wgid = (int)L; { const int q = nwg / NXCD, r = nwg % NXCD, xcd = wgid % NXCD, off = wgid / NXCD; wgid = (xcd < r ? xcd * (q + 1) : r * (q + 1) + (xcd - r) * q) + off; }
        const int nig = WGM * nN, gid = wgid / nig, fm = gid * WGM, gsz = (nM - fm) < WGM ? (nM - fm) : WGM;
        u.pm = fm + ((wgid % nig) % gsz); u.pn = (wgid % nig) / gsz; return true;
    }
    __device__ __forceinline__ const char* abase(const Unit& u) const { return A + (long)(u.pm >> ash) * am + (long)(u.pm & amask) * am2 + (long)u.pn * an; }
    __device__ __forceinline__ const char* bbase(const Unit& u) const { return B + (long)u.pn * bn + (long)(u.pm >> bsh) * bb + (long)(u.pm & bmask) * bg; }
};

__device__ __forceinline__ unsigned cvt_pk_bf16(float lo, float hi) { unsigned r; asm volatile("v_cvt_pk_bf16_f32 %0, %1, %2" : "=v"(r) : "v"(lo), "v"(hi)); return r; }
__device__ __forceinline__ u32x4 pack8(const f32x4 a, const f32x4 b) { u32x4 w; w.x = cvt_pk_bf16(a[0], a[1]); w.y = cvt_pk_bf16(a[2], a[3]); w.z = cvt_pk_bf16(b[0], b[1]); w.w = cvt_pk_bf16(b[2], b[3]); return w; }
__device__ __forceinline__ float bf_lo(unsigned w) { return __uint_as_float(w << 16); }
__device__ __forceinline__ float bf_hi(unsigned w) { return __uint_as_float(w & 0xffff0000u); }

enum { M_STORE = 0, M_SCALE, M_UP, M_CONVIN, M_RES, M_GLU, M_SOFT, M_STORE_N, M_G, M_Y };
__device__ __forceinline__ float gelu_tanh(float y) {
    const float z = 0.7978845608f * (y + 0.044715f * y * y * y);
    const float e = __builtin_amdgcn_exp2f(z * 2.8853900818f);
    const float t = 1.0f - 2.0f * __builtin_amdgcn_rcpf(1.0f + e);
    return 0.5f * y * (1.0f + t);
}
struct Epi {
    static constexpr bool PERM = true;
    int mode, ldc; float mul;
    bf16_t* o0; bf16_t* o1; const float* f0; const float* f1; float* f2; const bf16_t* b0;
    const unsigned long long* sin; unsigned long long* sout;
    __device__ __forceinline__ void operator()(f32x4 (&acc)[2][2][4][2], const Unit& u, int wr, int wc, int fr, int fq, PG8_LAS unsigned char* xlds) const {
        const int r0 = u.pm * 256 + wr * 64 + fr;
        const int cw = wc * 32 + 8 * fq;
        if (mode == M_STORE || mode == M_SCALE || mode == M_UP) {
            float rs[8];
            if (mode != M_STORE) { unsigned long long sv[8];
#pragma unroll
                for (int i = 0; i < 8; ++i) sv[i] = sin[r0 + (i >> 2) * 128 + (i & 3) * 16];
#pragma unroll
                for (int i = 0; i < 8; ++i) rs[i] = __builtin_amdgcn_rsqf((float)sv[i] * (1.0f / (1024.0f * 1048576.0f)) + 1e-6f) * mul;
            } else {
#pragma unroll
                for (int i = 0; i < 8; ++i) rs[i] = 1.0f; }
#pragma unroll
            for (int ai = 0; ai < 2; ++ai)
#pragma unroll
                for (int m = 0; m < 4; ++m) { const int row = r0 + ai * 128 + m * 16; const float r_ = rs[ai * 4 + m];
                    bf16_t* rowp = o0 + (size_t)row * ldc + u.pn * 256 + cw;
#pragma unroll
                    for (int bj = 0; bj < 2; ++bj) { f32x4 v0 = acc[ai][bj][m][0] * r_, v1 = acc[ai][bj][m][1] * r_;
                        if (mode == M_UP) {
#pragma unroll
                            for (int j = 0; j < 4; ++j) { const float a = fmaxf(v0[j], 0.f), b = fmaxf(v1[j], 0.f); v0[j] = a * a; v1[j] = b * b; } }
                        if (mode == M_UP) __builtin_nontemporal_store(pack8(v0, v1), (u32x4*)(rowp + bj * 128)); else *(u32x4*)(rowp + bj * 128) = pack8(v0, v1); } }
        } else if (mode == M_CONVIN) {
            float rs[8]; { unsigned long long sv[8];
#pragma unroll
                for (int i = 0; i < 8; ++i) sv[i] = sin[r0 + (i >> 2) * 128 + (i & 3) * 16];
#pragma unroll
                for (int i = 0; i < 8; ++i) rs[i] = __builtin_amdgcn_rsqf((float)sv[i] * (1.0f / (1024.0f * 1048576.0f)) + 1e-6f); }
#pragma unroll
            for (int ai = 0; ai < 2; ++ai)
#pragma unroll
                for (int m = 0; m < 4; ++m) { const int row = r0 + ai * 128 + m * 16; const float r_ = rs[ai * 4 + m];
                    if (u.pn < 4) { bf16_t* rowp = o0 + (size_t)row * 1024 + u.pn * 256 + cw;
#pragma unroll
                        for (int bj = 0; bj < 2; ++bj) *(u32x4*)(rowp + bj * 128) = pack8(acc[ai][bj][m][0] * r_, acc[ai][bj][m][1] * r_);
                    } else { bf16_t* rowp = o1 + (size_t)row * 1024 + (u.pn - 4) * 128 + cw; const float r2 = r_ * r_;
                        *(u32x4*)rowp = pack8(acc[ai][0][m][0] * acc[ai][1][m][0] * r2, acc[ai][0][m][1] * acc[ai][1][m][1] * r2); } }
        } else if (mode == M_RES) {
            bf16_t* const xb = o0 + (size_t)r0 * 1024 + u.pn * 256 + cw;
#pragma unroll
            for (int ai = 0; ai < 2; ++ai) { u32x4 xw[4][2];
#pragma unroll
                for (int m = 0; m < 4; ++m)
#pragma unroll
                    for (int bj = 0; bj < 2; ++bj) xw[m][bj] = *(const u32x4*)(xb + (size_t)(ai * 128 + m * 16) * 1024 + bj * 128);
                asm volatile("" ::: "memory");
#pragma unroll
                for (int m = 0; m < 4; ++m) { float ssq = 0.f;
#pragma unroll
                    for (int bj = 0; bj < 2; ++bj) { const u32x4 w = xw[m][bj];
                        f32x4 v0 = acc[ai][bj][m][0], v1 = acc[ai][bj][m][1];
                        v0[0] += bf_lo(w.x); v0[1] += bf_hi(w.x); v0[2] += bf_lo(w.y); v0[3] += bf_hi(w.y); v1[0] += bf_lo(w.z); v1[1] += bf_hi(w.z); v1[2] += bf_lo(w.w); v1[3] += bf_hi(w.w);
                        ssq += (v0[0] * v0[0] + v0[1] * v0[1]) + (v0[2] * v0[2] + v0[3] * v0[3]) + (v1[0] * v1[0] + v1[1] * v1[1]) + (v1[2] * v1[2] + v1[3] * v1[3]);
                        *(u32x4*)(xb + (size_t)(ai * 128 + m * 16) * 1024 + bj * 128) = pack8(v0, v1); }
                    if (sout) { ssq += __shfl_xor(ssq, 16); ssq += __shfl_xor(ssq, 32); if (fq == 0) atomicAdd(sout + r0 + ai * 128 + m * 16, (unsigned long long)(ssq * 1048576.0f + 0.5f)); } } }
        } else if (mode == M_GLU) {
            const size_t off0 = (size_t)r0 * 1024 + u.pn * 128 + cw;
#pragma unroll
            for (int ai = 0; ai < 2; ++ai) { f32x4 xv[4][2];
                if (f0) {
#pragma unroll
                    for (int m = 0; m < 4; ++m) { xv[m][0] = *(const f32x4*)(f0 + off0 + (size_t)(ai * 128 + m * 16) * 1024); xv[m][1] = *(const f32x4*)(f0 + off0 + (size_t)(ai * 128 + m * 16) * 1024 + 4); }
                } else { u32x4 xw[4];
#pragma unroll
                    for (int m = 0; m < 4; ++m) xw[m] = *(const u32x4*)(o0 + off0 + (size_t)(ai * 128 + m * 16) * 1024);
#pragma unroll
                    for (int m = 0; m < 4; ++m) { xv[m][0] = (f32x4){bf_lo(xw[m].x), bf_hi(xw[m].x), bf_lo(xw[m].y), bf_hi(xw[m].y)}; xv[m][1] = (f32x4){bf_lo(xw[m].z), bf_hi(xw[m].z), bf_lo(xw[m].w), bf_hi(xw[m].w)}; } }
                asm volatile("" ::: "memory");
#pragma unroll
                for (int m = 0; m < 4; ++m) { f32x4 v[2]; float ssq = 0.f; v[0] = xv[m][0]; v[1] = xv[m][1];
#pragma unroll
                    for (int n = 0; n < 2; ++n) { const f32x4 val = acc[ai][0][m][n], gate = acc[ai][1][m][n];
#pragma unroll
                        for (int j = 0; j < 4; ++j) { const float sg = __builtin_amdgcn_rcpf(1.0f + __builtin_amdgcn_exp2f(-1.4426950409f * gate[j])); v[n][j] += val[j] * sg; ssq += v[n][j] * v[n][j]; } }
                    *(u32x4*)(o0 + off0 + (size_t)(ai * 128 + m * 16) * 1024) = pack8(v[0], v[1]);
                    ssq += __shfl_xor(ssq, 16); ssq += __shfl_xor(ssq, 32); if (fq == 0) atomicAdd(sout + r0 + ai * 128 + m * 16, (unsigned long long)(ssq * 1048576.0f + 0.5f)); } }
        } else if (mode == M_SOFT) {
            PG8_LAS float* PS = (PG8_LAS float*)xlds + (wr * 64 + fr) * 4;
            const unsigned long long* sp = sin + r0;
#pragma unroll
            for (int ai = 0; ai < 2; ++ai)
#pragma unroll
                for (int m = 0; m < 4; ++m) { float sm = 0.f; const float r_ = __builtin_amdgcn_rsqf((float)sp[ai * 128 + m * 16] * (1.0f / (1024.0f * 1048576.0f)) + 1e-6f) * mul;
#pragma unroll
                    for (int bj = 0; bj < 2; ++bj)
#pragma unroll
                        for (int n = 0; n < 2; ++n)
#pragma unroll
                            for (int j = 0; j < 4; ++j) sm += __builtin_amdgcn_exp2f(acc[ai][bj][m][n][j] * r_);
                    sm += __shfl_xor(sm, 16); sm += __shfl_xor(sm, 32);
                    if (fq == 0) PS[(ai * 128 + m * 16) * 4 + wc] = sm; }
            asm volatile("s_waitcnt lgkmcnt(0)" ::: "memory"); __builtin_amdgcn_s_barrier(); asm volatile("" ::: "memory");
#pragma unroll
            for (int ai = 0; ai < 2; ++ai)
#pragma unroll
                for (int m = 0; m < 4; ++m) { const f32x4 ps = *(const PG8_LAS f32x4*)(PS + (ai * 128 + m * 16) * 4);
                    const float r_ = __builtin_amdgcn_rsqf((float)sp[ai * 128 + m * 16] * (1.0f / (1024.0f * 1048576.0f)) + 1e-6f) * mul;
                    const float inv = 1.0f / ((ps[0] + ps[1]) + (ps[2] + ps[3]));
                    bf16_t* rowp = o0 + (size_t)(r0 + ai * 128 + m * 16) * 1024 + u.pn * 256 + cw;
#pragma unroll
                    for (int bj = 0; bj < 2; ++bj) { f32x4 v0, v1;
#pragma unroll
                        for (int j = 0; j < 4; ++j) { v0[j] = __builtin_amdgcn_exp2f(acc[ai][bj][m][0][j] * r_) * inv; v1[j] = __builtin_amdgcn_exp2f(acc[ai][bj][m][1][j] * r_) * inv; }
                        *(u32x4*)(rowp + bj * 128) = pack8(v0, v1); } }
        } else if (mode == M_STORE_N) {
#pragma unroll
            for (int ai = 0; ai < 2; ++ai)
#pragma unroll
                for (int m = 0; m < 4; ++m) { bf16_t* rowp = o0 + ((size_t)(u.pm >> 2) * 1024 + u.pn * 256 + ai * 128 + wr * 64 + m * 16 + fr) * 1024 + (u.pm & 3) * 256 + cw;
#pragma unroll
                    for (int bj = 0; bj < 2; ++bj) *(u32x4*)(rowp + bj * 128) = pack8(acc[ai][bj][m][0], acc[ai][bj][m][1]); }
        } else if (mode == M_G) {
#pragma unroll
            for (int ai = 0; ai < 2; ++ai)
#pragma unroll
                for (int m = 0; m < 4; ++m) { float* p = f2 + (size_t)(r0 + ai * 128 + m * 16) * 128 + cw;
                    *(f32x4*)p = acc[ai][0][m][0]; *(f32x4*)(p + 4) = acc[ai][0][m][1]; }
        } else {
            const int b = u.pm >> 6, g = u.pm & 63, ho0 = (fq & 1) * 8;
            const f32x4 d0 = *(const f32x4*)(f1 + g * 16 + ho0), d1 = *(const f32x4*)(f1 + g * 16 + ho0 + 4);
            const bf16_t* const ub = b0 + ((size_t)u.pm * 256 + wr * 64 + fr) * 384 + (wc * 2 + (fq >> 1)) * 16 + ho0;
            bf16_t* const yb = o0 + ((size_t)b * 4096 + (wr * 64 + fr) * 16 + wc * 2 + (fq >> 1)) * 1024 + g * 16 + ho0;
#pragma unroll
            for (int ai = 0; ai < 2; ++ai) { u32x4 uw[4][2];
#pragma unroll
                for (int m = 0; m < 4; ++m)
#pragma unroll
                    for (int bj = 0; bj < 2; ++bj) uw[m][bj] = *(const u32x4*)(ub + (size_t)(ai * 128 + m * 16) * 384 + bj * 128);
                asm volatile("" ::: "memory");
#pragma unroll
                for (int m = 0; m < 4; ++m)
#pragma unroll
                    for (int bj = 0; bj < 2; ++bj) { const u32x4 w = uw[m][bj];
                        f32x4 v0 = acc[ai][bj][m][0], v1 = acc[ai][bj][m][1];
                        v0[0] += d0[0] * bf_lo(w.x); v0[1] += d0[1] * bf_hi(w.x); v0[2] += d0[2] * bf_lo(w.y); v0[3] += d0[3] * bf_hi(w.y);
                        v1[0] += d1[0] * bf_lo(w.z); v1[1] += d1[1] * bf_hi(w.z); v1[2] += d1[2] * bf_lo(w.w); v1[3] += d1[3] * bf_hi(w.w);
#pragma unroll
                        for (int j = 0; j < 4; ++j) { v0[j] = gelu_tanh(v0[j]); v1[j] = gelu_tanh(v1[j]); }
                        *(u32x4*)(yb + (size_t)(ai * 128 + m * 16) * 16384 + bj * 8192) = pack8(v0, v1); } }
        }
    }
};

template <class Epi, class Sched, bool ALIGN_EPI = false, bool SP2 = false>
__device__ __forceinline__ void gemm_phase(PG8_LAS unsigned char* lds, const int lda, const int ldb, const int K, const Sched& S, const Epi& E, const int tid) {
    const int wid = __builtin_amdgcn_readfirstlane(tid >> 6), lane = tid & 63, wr = wid >> 2, wc = wid & 3, fr = lane & 15, fq = lane >> 4;
    const int nt = K / BK;
    unsigned voffA[2], voffB[2];
#pragma unroll
    for (int i = 0; i < 2; ++i) { int R, C; stage_rc(tid * 16 + i * 8192, R, C); const int Rb = Epi::PERM ? ((R & ~31) + perm32(R & 31)) : R;
        voffA[i] = (unsigned)(R * lda + C) * 2u; voffB[i] = (unsigned)(Rb * ldb + C) * 2u; }
    const size_t kstep = (size_t)(BK * 2);
    const size_t hstepA = (size_t)HALF * lda * 2, hstepB = (size_t)HALF * ldb * 2;
    const unsigned ldsw = (unsigned)wid * 1024u;
    const int aoff = lds_byte(wr * 64 + fr, fq * 8), boff = lds_byte(wc * 32 + fr, fq * 8);
#define PG8_SA(b, h) (((b) * 2 + (h)) * HTB)
#define PG8_SB(b, h) ((4 + (b) * 2 + (h)) * HTB)
#define PG8_STAGE(bufoff, gbase, voff) do { _Pragma("unroll") for (int _i = 0; _i < 2; ++_i) \
        __builtin_amdgcn_global_load_lds((const unsigned*)((const char*)(gbase) + (voff)[_i]), (PG8_LAS unsigned*)(lds + (bufoff) + ldsw + _i * 8192), 16, 0, 0); } while (0)
#define PG8_LDA(dst, b, h) do { _Pragma("unroll") for (int m = 0; m < 4; ++m) _Pragma("unroll") for (int k = 0; k < 2; ++k) dst[m][k] = *(const PG8_LAS bf16x8*)(lds + PG8_SA(b, h) + aoff + m * 2048 + k * 1024); } while (0)
#define PG8_LDB(dst, b, h) do { _Pragma("unroll") for (int n = 0; n < 2; ++n) _Pragma("unroll") for (int k = 0; k < 2; ++k) dst[n][k] = *(const PG8_LAS bf16x8*)(lds + PG8_SB(b, h) + boff + n * 2048 + k * 1024); } while (0)
#define PG8_MMA(ai, bj, At, Bt) do { __builtin_amdgcn_s_setprio(1); _Pragma("unroll") for (int m = 0; m < 4; ++m) _Pragma("unroll") for (int n = 0; n < 2; ++n) _Pragma("unroll") for (int k = 0; k < 2; ++k) \
        acc[ai][bj][m][n] = __builtin_amdgcn_mfma_f32_16x16x32_bf16(Bt[n][k], At[m][k], acc[ai][bj][m][n], 0, 0, 0); __builtin_amdgcn_s_setprio(0); } while (0)
#define PG8_WAIT_V(n) asm volatile("s_waitcnt vmcnt(" #n ")" ::: "memory")
#define PG8_WAIT_L(n) asm volatile("s_waitcnt lgkmcnt(" #n ")" ::: "memory")
#define PG8_BAR __builtin_amdgcn_s_barrier()
#define PG8_SCHED __builtin_amdgcn_sched_barrier(0)
    Unit cur, nxt; int ui = 0;
    if (!S.next(0, cur)) return;
    f32x4 acc[2][2][4][2];
#pragma unroll
    for (int a = 0; a < 2; ++a)
#pragma unroll
        for (int b = 0; b < 2; ++b)
#pragma unroll
            for (int m = 0; m < 4; ++m)
#pragma unroll
                for (int n = 0; n < 2; ++n) acc[a][b][m][n] = (f32x4){0.f, 0.f, 0.f, 0.f};
    bf16x8 At[4][2], B0[2][2], B1[2][2];
    const char* cA = S.abase(cur); const char* cB = S.bbase(cur);
    if constexpr (SP2) {
        PG8_STAGE(PG8_SB(0, 0), cB, voffB); PG8_STAGE(PG8_SB(0, 1), cB + hstepB, voffB); PG8_STAGE(PG8_SA(0, 0), cA, voffA); PG8_STAGE(PG8_SA(0, 1), cA + hstepA, voffA);
        if (wr == 1) PG8_BAR;
        PG8_WAIT_V(2); PG8_BAR;
        PG8_STAGE(PG8_SB(1, 0), cB + kstep, voffB); PG8_STAGE(PG8_SA(1, 0), cA + kstep, voffA); PG8_STAGE(PG8_SB(1, 1), cB + hstepB + kstep, voffB);
        PG8_WAIT_V(6); PG8_BAR;
    } else {
        PG8_STAGE(PG8_SB(0, 0), cB, voffB); PG8_STAGE(PG8_SA(0, 0), cA, voffA); PG8_STAGE(PG8_SB(0, 1), cB + hstepB, voffB); PG8_STAGE(PG8_SA(0, 1), cA + hstepA, voffA);
        if (wr == 1) PG8_BAR;
        PG8_WAIT_V(4); PG8_BAR;
        PG8_STAGE(PG8_SB(1, 0), cB + kstep, voffB); PG8_STAGE(PG8_SA(1, 0), cA + kstep, voffA); PG8_STAGE(PG8_SB(1, 1), cB + hstepB + kstep, voffB);
        PG8_WAIT_V(6); PG8_BAR;
    }
    for (;;) {
        const bool has_next = S.next(ui + 1, nxt);
        const char* nA = has_next ? S.abase(nxt) : cA; const char* nB = has_next ? S.bbase(nxt) : cB;
        for (int t = 0; t < nt; t += 2) {
            const bool last = (t == nt - 2);
            const char* a1 = cA + (size_t)(t + 1) * kstep;
            const char* a2 = last ? nA : cA + (size_t)(t + 2) * kstep; const char* b2 = last ? nB : cB + (size_t)(t + 2) * kstep;
            const char* a3 = a2 + kstep; const char* b3 = b2 + kstep;
            if constexpr (SP2) {
            PG8_LDB(B0, 0, 0); PG8_LDB(B1, 0, 1); PG8_SCHED; PG8_LDA(At, 0, 0); PG8_STAGE(PG8_SA(1, 1), a1 + hstepA, voffA);
            PG8_WAIT_V(8); PG8_WAIT_L(0); PG8_BAR; PG8_MMA(0, 0, At, B0); PG8_MMA(0, 1, At, B1); PG8_BAR; PG8_SCHED;
            PG8_LDA(At, 0, 1); PG8_STAGE(PG8_SB(0, 0), b2, voffB); PG8_STAGE(PG8_SB(0, 1), b2 + hstepB, voffB); PG8_STAGE(PG8_SA(0, 0), a2, voffA);
            PG8_WAIT_V(8); PG8_WAIT_L(0); PG8_BAR; PG8_MMA(1, 0, At, B0); PG8_MMA(1, 1, At, B1); PG8_BAR; PG8_SCHED;
            PG8_LDB(B0, 1, 0); PG8_LDB(B1, 1, 1); PG8_SCHED; PG8_LDA(At, 1, 0); PG8_STAGE(PG8_SA(0, 1), a2 + hstepA, voffA);
            PG8_WAIT_V(8); PG8_WAIT_L(0); PG8_BAR; PG8_MMA(0, 0, At, B0); PG8_MMA(0, 1, At, B1); PG8_BAR; PG8_SCHED;
            PG8_LDA(At, 1, 1); PG8_STAGE(PG8_SB(1, 0), b3, voffB); PG8_STAGE(PG8_SB(1, 1), b3 + hstepB, voffB); PG8_STAGE(PG8_SA(1, 0), a3, voffA);
            PG8_WAIT_V(8); PG8_WAIT_L(0); PG8_BAR; PG8_MMA(1, 0, At, B0); PG8_MMA(1, 1, At, B1); PG8_BAR; PG8_SCHED;
            } else {
            PG8_LDB(B0, 0, 0); PG8_SCHED; PG8_LDA(At, 0, 0); PG8_STAGE(PG8_SA(1, 1), a1 + hstepA, voffA);
            PG8_WAIT_L(8); PG8_BAR; PG8_WAIT_L(0); PG8_MMA(0, 0, At, B0); PG8_BAR; PG8_SCHED;
            PG8_LDB(B1, 0, 1); PG8_STAGE(PG8_SB(0, 0), b2, voffB);
            PG8_BAR; PG8_WAIT_L(0); PG8_MMA(0, 1, At, B1); PG8_BAR;
            PG8_LDA(At, 0, 1); PG8_STAGE(PG8_SA(0, 0), a2, voffA);
            PG8_BAR; PG8_WAIT_L(0); PG8_MMA(1, 0, At, B0); PG8_BAR; PG8_SCHED;
            PG8_STAGE(PG8_SB(0, 1), b2 + hstepB, voffB);
            PG8_WAIT_V(6); PG8_BAR; PG8_MMA(1, 1, At, B1); PG8_BAR;
            PG8_LDB(B0, 1, 0); PG8_SCHED; PG8_LDA(At, 1, 0); PG8_STAGE(PG8_SA(0, 1), a2 + hstepA, voffA);
            PG8_WAIT_L(8); PG8_BAR; PG8_WAIT_L(0); PG8_MMA(0, 0, At, B0); PG8_BAR; PG8_SCHED;
            PG8_LDB(B1, 1, 1); PG8_STAGE(PG8_SB(1, 0), b3, voffB);
            PG8_BAR; PG8_WAIT_L(0); PG8_MMA(0, 1, At, B1); PG8_BAR;
            PG8_LDA(At, 1, 1); PG8_STAGE(PG8_SA(1, 0), a3, voffA);
            PG8_BAR; PG8_WAIT_L(0); PG8_MMA(1, 0, At, B0); PG8_BAR; PG8_SCHED;
            PG8_STAGE(PG8_SB(1, 1), b3 + hstepB, voffB);
            PG8_WAIT_V(6); PG8_BAR; PG8_MMA(1, 1, At, B1); PG8_BAR;
            }
        }
        if constexpr (ALIGN_EPI) { if (wr == 0) PG8_BAR; }
        { int frv = fr, fqv = fq; asm volatile("" : "+v"(frv), "+v"(fqv)); E(acc, cur, wr, wc, frv, fqv, lds + 131072 + 1024); }
        if (!has_next) break;
#pragma unroll
        for (int a = 0; a < 2; ++a)
#pragma unroll
            for (int b = 0; b < 2; ++b)
#pragma unroll
                for (int m = 0; m < 4; ++m)
#pragma unroll
                    for (int n = 0; n < 2; ++n) acc[a][b][m][n] = (f32x4){0.f, 0.f, 0.f, 0.f};
        cur = nxt; cA = nA; cB = nB; ++ui;
        if constexpr (ALIGN_EPI) { if (wr == 1) PG8_BAR; }
    }
    PG8_WAIT_V(0);
    if constexpr (!ALIGN_EPI) { if (wr == 0) PG8_BAR; }
    PG8_BAR;
#undef PG8_SA
#undef PG8_SB
#undef PG8_STAGE
#undef PG8_LDA
#undef PG8_LDB
#undef PG8_MMA
#undef PG8_WAIT_V
#undef PG8_WAIT_L
#undef PG8_BAR
#undef PG8_SCHED
}
}
using pg8::bf16_t; using pg8::f32x4; using pg8::u32x4; using pg8::u32x2;
#define LAS __attribute__((address_space(3)))

constexpr int BATCH = 8, SEQ = 4096, D = 1024, T = BATCH * SEQ, DEPTH = 4, NMEM = 256, HEADS = 4, HD = 256, FF = 4096;
constexpr int SG = 64, SP = 64, SH = 16, CL = 16, NCH = SEQ / CL;
constexpr int KX = CL * SH + 2 * SP;
constexpr float EPS = 1e-6f;
constexpr int NWAVES = 8, NTHR = 512;
constexpr int LDS_BYTES = 147456;

constexpr size_t MiB = 1u << 20;
constexpr size_t WS_SS = 0;
constexpr size_t WS_L = 4 * MiB;
constexpr size_t WS_ZERO_BYTES = 8 * MiB;
constexpr size_t WS_TAB = 8 * MiB;
constexpr size_t WS_F = 9 * MiB;
constexpr size_t WS_W2X = 14 * MiB;
constexpr size_t WS_MEMN = 26 * MiB;
constexpr size_t WS_KB = 30 * MiB;
constexpr size_t WS_VT = 46 * MiB;
constexpr size_t WS_WGLU = 62 * MiB, WS_WIN = 70 * MiB, WS_WOUT = 82 * MiB, WS_WQ = 86 * MiB, WS_WK = 94 * MiB, WS_WV = 102 * MiB, WS_WO = 110 * MiB, WS_W1 = 118 * MiB, WS_W2 = 150 * MiB;
constexpr size_t WS_XG = 182 * MiB;
constexpr size_t WS_BIG = 246 * MiB;
constexpr size_t WS_BAR = 502 * MiB;
constexpr size_t WS_END = 503 * MiB;
constexpr size_t BG_H = 0, BG_P = 0, BG_MB = 64 * MiB, BG_NB = 80 * MiB, BG_BC = 0, BG_Z = 64 * MiB, BG_UC = 128 * MiB, BG_UEXT = 0, BG_G = 96 * MiB, BG_Y = 160 * MiB;

struct Args { const float* in[24]; float* out; unsigned char* ws; };

__device__ __forceinline__ float wave_sum(float v) {
#pragma unroll
    for (int o = 1; o < 64; o <<= 1) v += __shfl_xor(v, o);
    return v;
}
__device__ __forceinline__ unsigned f2bf(float f) { unsigned u = __float_as_uint(f); return (u + 0x7fffu + ((u >> 16) & 1u)) >> 16; }
__device__ __forceinline__ unsigned pk2(float lo, float hi) { return f2bf(lo) | (f2bf(hi) << 16); }

__device__ __forceinline__ void transpose_item(const float* W, int K, int N, bf16_t* drow0, int k0, int n0, const float* gain, LAS float* scr, int lane) {
    const float gl = gain ? gain[k0 + lane] : 1.0f;
    float wv[32];
    const float* wp = W + (size_t)(k0 + (lane >> 5)) * N + n0 + (lane & 31);
#pragma unroll
    for (int i = 0; i < 32; ++i) wv[i] = __builtin_nontemporal_load(wp + (size_t)(2 * i) * N);
    asm volatile("" ::: "memory");
#pragma unroll
    for (int i = 0; i < 32; ++i) { const int kk = 2 * i + (lane >> 5); scr[kk * 33 + (lane & 31)] = wv[i] * __shfl(gl, kk); }
    asm volatile("s_waitcnt lgkmcnt(0)" ::: "memory");
    const int c = lane & 7;
#pragma unroll
    for (int j = 0; j < 4; ++j) { const int n = (lane >> 3) + 8 * j; const LAS float* s = scr + (8 * c) * 33 + n;
        u32x4 o; o.x = pk2(s[0 * 33], s[1 * 33]); o.y = pk2(s[2 * 33], s[3 * 33]); o.z = pk2(s[4 * 33], s[5 * 33]); o.w = pk2(s[6 * 33], s[7 * 33]);
        *(u32x4*)(drow0 + (size_t)n * K + k0 + 8 * c) = o; }
    asm volatile("s_waitcnt lgkmcnt(0)" ::: "memory");
}

__device__ __forceinline__ void rms_row(const float* xrow, const float* gain, int lane, f32x4 (&v)[4]) {
    const f32x4* xr = (const f32x4*)xrow + lane; const f32x4* gr = (const f32x4*)gain + lane; float s = 0.f;
#pragma unroll
    for (int j = 0; j < 4; ++j) { v[j] = xr[64 * j]; s += (v[j][0] * v[j][0] + v[j][1] * v[j][1]) + (v[j][2] * v[j][2] + v[j][3] * v[j][3]); }
    const float rstd = 1.0f / sqrtf(wave_sum(s) * (1.0f / D) + EPS);
#pragma unroll
    for (int j = 0; j < 4; ++j) v[j] = v[j] * rstd * gr[64 * j];
}

__device__ __forceinline__ void rms_row_bf(const bf16_t* xrow, const float* gain, int lane, f32x4 (&v)[4]) {
    const u32x2* xr = (const u32x2*)xrow + lane; const f32x4* gr = (const f32x4*)gain + lane; float s = 0.f;
#pragma unroll
    for (int j = 0; j < 4; ++j) { const u32x2 w = xr[64 * j]; v[j] = (f32x4){pg8::bf_lo(w.x), pg8::bf_hi(w.x), pg8::bf_lo(w.y), pg8::bf_hi(w.y)}; s += (v[j][0] * v[j][0] + v[j][1] * v[j][1]) + (v[j][2] * v[j][2] + v[j][3] * v[j][3]); }
    const float rstd = 1.0f / sqrtf(wave_sum(s) * (1.0f / D) + EPS);
#pragma unroll
    for (int j = 0; j < 4; ++j) v[j] = v[j] * rstd * gr[64 * j];
}

template <bool BF> __device__ __forceinline__ void norm_chunk_to_uext(const void* x, const float* gain, bf16_t* uext, int ci, LAS unsigned char* lds, int wave, int lane) {
    const int b = ci >> 8, c = ci & 255; const size_t t0 = (size_t)b * SEQ + c * CL;
    constexpr int PITCH = 2064;
    f32x4 vv[2][4];
#pragma unroll
    for (int r = 0; r < 2; ++r) { const int tok = r * 8 + wave;
        if (BF) { const u32x2* xr = (const u32x2*)((const bf16_t*)x + (t0 + tok) * D) + lane;
#pragma unroll
            for (int j = 0; j < 4; ++j) { const u32x2 w = xr[64 * j]; vv[r][j] = (f32x4){pg8::bf_lo(w.x), pg8::bf_hi(w.x), pg8::bf_lo(w.y), pg8::bf_hi(w.y)}; } }
        else { const f32x4* xr = (const f32x4*)((const float*)x + (t0 + tok) * D) + lane;
#pragma unroll
            for (int j = 0; j < 4; ++j) vv[r][j] = xr[64 * j]; } }
#pragma unroll
    for (int r = 0; r < 2; ++r) { const int tok = r * 8 + wave; float ss = 0.f; const f32x4* gr = (const f32x4*)gain + lane;
#pragma unroll
        for (int j = 0; j < 4; ++j) ss += (vv[r][j][0] * vv[r][j][0] + vv[r][j][1] * vv[r][j][1]) + (vv[r][j][2] * vv[r][j][2] + vv[r][j][3] * vv[r][j][3]);
        const float rstd = 1.0f / sqrtf(wave_sum(ss) * (1.0f / D) + EPS);
#pragma unroll
        for (int j = 0; j < 4; ++j) { const f32x4 v = vv[r][j] * rstd * gr[64 * j]; u32x2 w; w.x = pk2(v[0], v[1]); w.y = pk2(v[2], v[3]); *(LAS u32x2*)(lds + tok * PITCH + (4 * lane + 256 * j) * 2) = w; } }
    __syncthreads();
    const int l32 = lane & 31, tk = l32 >> 1, half = l32 & 1;
#pragma unroll
    for (int gi = 0; gi < 8; gi += 2) { const int g = wave * 8 + gi + (lane >> 5);
        const u32x4 w = *(const LAS u32x4*)(lds + tk * PITCH + (g * 16 + half * 8) * 2);
        *(u32x4*)(uext + ((size_t)(b * 64 + g) * 256 + c) * KX + tk * 16 + half * 8) = w; }
    __syncthreads();
}

struct SsmIn { const float *a_re, *a_im, *log_dt, *b_re, *b_im, *c_re, *c_im; unsigned char* ws; };
__device__ __forceinline__ void build_ssm(const SsmIn& a, int j, int g, LAS unsigned char* lds, int tid) {
    typedef float f32x2 __attribute__((ext_vector_type(2)));
    LAS f32x2* pw = (LAS f32x2*)lds;
    LAS f32x2* bb = (LAS f32x2*)(lds + 8704);
    LAS f32x2* cc = (LAS f32x2*)(lds + 16896);
    LAS float* kk = (LAS float*)(lds + 25088);
    const float* a_re = a.a_re + (size_t)(j * SG + g) * SP; const float* a_im = a.a_im + (size_t)(j * SG + g) * SP;
    const float dt = expf(a.log_dt[j * SG + g]);
    const float* b_re = a.b_re + (size_t)(j * SG + g) * SP * SH; const float* b_im = a.b_im + (size_t)(j * SG + g) * SP * SH;
    const float* c_re = a.c_re + (size_t)(j * SG + g) * SH * SP; const float* c_im = a.c_im + (size_t)(j * SG + g) * SH * SP;
    if (tid < 64) { const float are = a_re[tid], aim = a_im[tid];
        for (int k = 0; k <= 16; ++k) { const float mag = expf(are * dt * (float)k); double ang = (double)aim * (double)dt * (double)k; ang -= 6.283185307179586 * rint(ang * 0.15915494309189535);
            float sn, cs; sincosf((float)ang, &sn, &cs); pw[k * 64 + tid] = (f32x2){mag * cs, mag * sn}; }
        const float mag = expf(are * dt * 1024.0f); double ang = (double)aim * (double)dt * 1024.0; ang -= 6.283185307179586 * rint(ang * 0.15915494309189535);
        float sn, cs; sincosf((float)ang, &sn, &cs);
        f32x4 t; t[0] = pw[16 * 64 + tid].x; t[1] = pw[16 * 64 + tid].y; t[2] = mag * cs; t[3] = mag * sn;
        *(f32x4*)(a.ws + WS_TAB + ((size_t)g * 64 + tid) * 16) = t; }
    __syncthreads();
    for (int idx = tid; idx < 1024; idx += NTHR) { const int p = idx >> 4;
        const float are = a_re[p], aim = a_im[p]; const f32x2 ab = pw[64 + p];
        const float nr = ab.x - 1.0f, ni = ab.y, den = 1.0f / (are * are + aim * aim);
        const float qr = (nr * are + ni * aim) * den, qi = (ni * are - nr * aim) * den;
        const float br = b_re[idx], bi = b_im[idx];
        bb[idx] = (f32x2){qr * br - qi * bi, qr * bi + qi * br};
        cc[idx] = (f32x2){c_re[idx], c_im[idx]}; }
    __syncthreads();
    for (int idx = tid; idx < 4096; idx += NTHR) { const int k = idx >> 8, ho = (idx >> 4) & 15, hi = idx & 15; float s = 0.f;
        for (int p = 0; p < 64; ++p) { const f32x2 c = cc[ho * 64 + p], w = pw[k * 64 + p], bq = bb[p * 16 + hi];
            const float tr = c.x * w.x - c.y * w.y, ti = c.x * w.y + c.y * w.x; s += tr * bq.x - ti * bq.y; }
        kk[idx] = s; }
    __syncthreads();
    unsigned* w2 = (unsigned*)(a.ws + WS_W2X) + (size_t)g * 256 * (KX / 2);
    for (int idx = tid; idx < 256 * (KX / 2); idx += NTHR) { const int n = idx / (KX / 2), kc = (idx % (KX / 2)) * 2, jt = n >> 4, ho = n & 15; float v0, v1;
        if (kc < 256) { const int i = kc >> 4, hi = kc & 15; if (i <= jt) { v0 = kk[((jt - i) * 16 + ho) * 16 + hi]; v1 = kk[((jt - i) * 16 + ho) * 16 + hi + 1]; } else { v0 = 0.f; v1 = 0.f; } }
        else { const int p = (kc - 256) & 63; const f32x2 c0 = cc[ho * 64 + p], c1 = cc[ho * 64 + p + 1], w0 = pw[(jt + 1) * 64 + p], w1 = pw[(jt + 1) * 64 + p + 1];
            if (kc < 320) { v0 = c0.x * w0.x - c0.y * w0.y; v1 = c1.x * w1.x - c1.y * w1.y; } else { v0 = -(c0.x * w0.y + c0.y * w0.x); v1 = -(c1.x * w1.y + c1.y * w1.x); } }
        w2[idx] = pk2(v0, v1); }
    unsigned* fm = (unsigned*)(a.ws + WS_F) + (size_t)g * 128 * 128;
    for (int idx = tid; idx < 128 * 128; idx += NTHR) { const int n = idx >> 7, kc = (idx & 127) * 2, p = n & 63, i = kc >> 4, hi = kc & 15;
        const f32x2 w = pw[(15 - i) * 64 + p], q0 = bb[p * 16 + hi], q1 = bb[p * 16 + hi + 1]; float v0, v1;
        if (n < 64) { v0 = w.x * q0.x - w.y * q0.y; v1 = w.x * q1.x - w.y * q1.y; } else { v0 = w.x * q0.y + w.y * q0.x; v1 = w.x * q1.y + w.y * q1.x; }
        fm[idx] = pk2(v0, v1); }
    __syncthreads();
}

__device__ __forceinline__ void ssm_scan(unsigned char* ws_, LAS unsigned char* lds, const pg8::Order& S, int wave, int lane) {
    struct { unsigned char* ws; } a; a.ws = ws_;
    typedef float f32x2 __attribute__((ext_vector_type(2)));
    LAS f32x2* ex = (LAS f32x2*)lds;
    const float* Gb = (const float*)(a.ws + WS_BIG + BG_G); bf16_t* ue = (bf16_t*)(a.ws + WS_BIG + BG_UEXT);
    for (int i = 0; ; i += 2) {
        pg8::Unit u0, u1; if (!S.next(i, u0)) break; const bool has1 = S.next(i + 1, u1);
        const int bg = (wave >> 2) ? (has1 ? u1.pm : u0.pm) : u0.pm, seg = wave & 3, g = bg & 63, p = lane; const bool live = (wave >> 2) == 0 || has1;
        const f32x4 tb = *(const f32x4*)(a.ws + WS_TAB + ((size_t)g * 64 + p) * 16);
        const float* gp = Gb + ((size_t)bg * 256 + seg * 64) * 128 + p;
        float er = 0.f, ei = 0.f;
        for (int c0 = 0; c0 < 64; c0 += 16) { float gr[16], gi[16];
#pragma unroll
            for (int k = 0; k < 16; ++k) { gr[k] = gp[(size_t)(c0 + k) * 128]; gi[k] = gp[(size_t)(c0 + k) * 128 + 64]; }
#pragma unroll
            for (int k = 0; k < 16; ++k) { const float nr = tb[0] * er - tb[1] * ei + gr[k], ni = tb[0] * ei + tb[1] * er + gi[k]; er = nr; ei = ni; } }
        ex[wave * 64 + p] = (f32x2){er, ei};
        __syncthreads();
        float sr = 0.f, si = 0.f;
        for (int s = 0; s < seg; ++s) { const f32x2 e = ex[((wave & 4) + s) * 64 + p]; const float nr = tb[2] * sr - tb[3] * si + e.x, ni = tb[2] * si + tb[3] * sr + e.y; sr = nr; si = ni; }
        bf16_t* up = ue + ((size_t)bg * 256 + seg * 64) * KX + 256 + p;
        for (int c0 = 0; c0 < 64; c0 += 16) { float gr[16], gi[16];
#pragma unroll
            for (int k = 0; k < 16; ++k) { gr[k] = gp[(size_t)(c0 + k) * 128]; gi[k] = gp[(size_t)(c0 + k) * 128 + 64]; }
#pragma unroll
            for (int k = 0; k < 16; ++k) { if (live) { up[(size_t)(c0 + k) * KX] = (bf16_t)f2bf(sr); up[(size_t)(c0 + k) * KX + 64] = (bf16_t)f2bf(si); }
                const float nr = tb[0] * sr - tb[1] * si + gr[k], ni = tb[0] * si + tb[1] * sr + gi[k]; sr = nr; si = ni; } }
        __syncthreads();
    }
}

#define XB_TMO      128
#define XB_XCNT(j)  (256  + 64 * (j))
#define XB_XSUB(j)  (1280 + 64 * (j))
#define XB_XGEN(j)  (2304 + 64 * (j))
#define XB_TOP      3328
#define XB_TOPGEN   3392
#define XCD_BAR_WORDS 3456
#define XB_SPIN_CAP (1u << 22)
__device__ __forceinline__ unsigned xb_ld(unsigned* p)              { return __hip_atomic_load(p, __ATOMIC_RELAXED, __HIP_MEMORY_SCOPE_AGENT); }
__device__ __forceinline__ unsigned xb_add(unsigned* p, unsigned v) { return __hip_atomic_fetch_add(p, v, __ATOMIC_RELAXED, __HIP_MEMORY_SCOPE_AGENT); }
__device__ __forceinline__ unsigned xb_xcc_id() { return (unsigned)__builtin_amdgcn_s_getreg((3 << 11) | 20) & 0xFu; }
#define XB_SPIN(cond, bar) do { unsigned _sp = 0; while (cond) { __builtin_amdgcn_s_sleep(1); \
    if ((++_sp & 255u) == 0u) { if (xb_ld(&(bar)[XB_TMO])) break; if (_sp > XB_SPIN_CAP) { atomicAdd(&(bar)[XB_TMO], 1u); break; } } } } while (0)
struct XcdBarrier { unsigned* bar; unsigned x; volatile LAS unsigned* st; };
__device__ __forceinline__ XcdBarrier xcd_barrier_post(unsigned* bar, volatile LAS unsigned* st) {
    XcdBarrier b; b.bar = bar; b.x = xb_xcc_id(); b.st = st;
    if (threadIdx.x == 0) (void)xb_add(&bar[XB_XCNT(b.x)], 1u);
    return b;
}
__device__ __forceinline__ void xcd_barrier_complete(unsigned* bar, unsigned x, unsigned& nloc, unsigned& nx) {
    const unsigned G = gridDim.x * gridDim.y * gridDim.z;
    unsigned sum, cnt, mine, sp = 0u;
    for (;;) {
        sum = 0u; cnt = 0u; mine = 0u;
#pragma unroll
        for (unsigned j = 0; j < 16; ++j) { const unsigned c = xb_ld(&bar[XB_XCNT(j)]); sum += c; cnt += (c > 0u) ? 1u : 0u; mine = (j == x) ? c : mine; }
        if (sum == G) break;
        __builtin_amdgcn_s_sleep(1);
        if ((++sp & 255u) == 0u) { if (xb_ld(&bar[XB_TMO])) break; if (sp > XB_SPIN_CAP) { atomicAdd(&bar[XB_TMO], 1u); break; } }
    }
    nloc = mine > 0u ? mine : 1u; nx = cnt > 0u ? cnt : 1u;
}
__device__ __forceinline__ void xcd_barrier(const XcdBarrier& b) {
    asm volatile("s_waitcnt vmcnt(0)" ::: "memory");
    __syncthreads();
    if (threadIdx.x == 0) {
        unsigned* bar = b.bar;
        __builtin_amdgcn_s_waitcnt(0);
        unsigned nloc = b.st[0], nx = b.st[1];
        if (nloc == 0u) { xcd_barrier_complete(bar, b.x, nloc, nx); b.st[0] = nloc; b.st[1] = nx; }
        const unsigned old = xb_add(&bar[XB_XSUB(b.x)], 1u);
        const unsigned gen = old / nloc;
        if (old + 1u == (gen + 1u) * nloc) {
            __builtin_amdgcn_fence(__ATOMIC_RELEASE, "agent");
            asm volatile("s_waitcnt vmcnt(0)" ::: "memory");
            const unsigned og = xb_add(&bar[XB_TOP], 1u);
            const unsigned tg = og / nx;
            if (og + 1u == (tg + 1u) * nx) xb_add(&bar[XB_TOPGEN], 1u);
            else XB_SPIN(xb_ld(&bar[XB_TOPGEN]) == tg, bar);
            __builtin_amdgcn_fence(__ATOMIC_ACQUIRE, "agent");
            xb_add(&bar[XB_XGEN(b.x)], 1u);
            asm volatile("s_waitcnt vmcnt(0)" ::: "memory");
        } else {
            XB_SPIN(xb_ld(&bar[XB_XGEN(b.x)]) == gen, bar);
            __builtin_amdgcn_fence(__ATOMIC_ACQUIRE, "agent");
            asm volatile("s_waitcnt vmcnt(0)" ::: "memory");
        }
    }
    __syncthreads();
}

enum { PH_P0 = 0, PH_KVK, PH_KVV, PH_SSM1, PH_SCAN, PH_SSM3, PH_GLU, PH_Q  , PH_SP  , PH_OV  , PH_WO  , PH_UP, PH_DOWN, PH_CONVIN, PH_CONV, PH_CONVOUT, PH_NORM2, PH_FINAL };
constexpr int NPROG = 43;
#ifndef PROBE_REP_MASK
#define PROBE_REP_MASK 0u
#endif
#ifndef PROBE_P0_PARTS
#define PROBE_P0_PARTS 0u
#endif
#ifndef PROBE_SYNC_REP
#define PROBE_SYNC_REP 1
#endif

__global__ void __launch_bounds__(NTHR, 2) mega_fwd(Args a) {
    extern __shared__ __attribute__((aligned(16))) unsigned char lds_raw[];
    cg::grid_group grid = cg::this_grid();
    LAS unsigned char* lds = (LAS unsigned char*)lds_raw;
    const int Gn = gridDim.x, bx = blockIdx.x, wave0 = __builtin_amdgcn_readfirstlane((int)(threadIdx.x >> 6));
    const int vcu = (Gn % 8 == 0) ? (bx % 8) * (Gn / 8) + bx / 8 : bx;
    const int NGW = Gn * NWAVES;
#define AS4 __attribute__((address_space(4)))
    { unsigned char* ws = a.ws;
    if (threadIdx.x < 8) ((LAS unsigned*)(lds + 131072 + 64))[threadIdx.x] = 0u;
    __syncthreads();
    (void)xcd_barrier_post((unsigned*)(ws + WS_BAR), (volatile LAS unsigned*)(lds + 131072 + 64)); }

#pragma nounroll
    for (int pi = 0; pi < NPROG; ++pi) {
        int ph, l = 0;
        if (pi < 3) ph = pi;
        else { int q = pi - 3;
            if (q == 19) ph = PH_NORM2; else if (q == 39) ph = PH_FINAL;
            else { if (q >= 20) { q -= 20; l = 2; } int r = q; if (q >= 10) { r = q - 10; l += 1; }
                if (l & 1) ph = (r < 3) ? PH_CONVIN + r : PH_Q + (r - 3); else ph = (r < 4) ? PH_SSM1 + r : PH_Q + (r - 4); } }
        const int j = l >> 1;
        const AS4 char* kp = (const AS4 char*)__builtin_amdgcn_kernarg_segment_ptr(); asm volatile("" : "+s"(kp));
#define INP(k) (*(const float* const AS4*)(kp + 8 * (k)))
        unsigned char* const ws = *(unsigned char* const AS4*)(kp + 200);
        float* const xres = *(float* const AS4*)(kp + 192);
        bf16_t* const XG = (bf16_t*)(ws + WS_XG);
        unsigned char* const big = ws + WS_BIG;
        int lanev = (int)__builtin_amdgcn_mbcnt_hi(~0u, __builtin_amdgcn_mbcnt_lo(~0u, 0u)); asm volatile("" : "+v"(lanev));
        const int lane = lanev, wave = wave0, tid = wave * 64 + lane, gw = vcu * NWAVES + wave;
        bool is_gemm = true, do_sync = true, local_seam = false;
        pg8::Order S; pg8::Epi E; int lda = D, ldb = D, K = D;
        S.G = Gn; S.c = bx; S.an = 0; S.bb = 0; S.bg = 0; S.ash = 0; S.amask = 0; S.am2 = 0; S.bsh = 4; S.bmask = 63; S.nM = T / 256; S.nN = 4; S.A = nullptr; S.B = nullptr; S.am = 256L * D * 2; S.bn = 256L * D * 2;
        E.mode = pg8::M_STORE; E.ldc = D; E.mul = 1.0f; E.o0 = nullptr; E.o1 = nullptr; E.f0 = nullptr; E.f1 = nullptr; E.f2 = nullptr; E.b0 = nullptr; E.sin = nullptr; E.sout = nullptr;
        unsigned long long* const SSb = (unsigned long long*)(ws + WS_SS); unsigned long long* const Lb = (unsigned long long*)(ws + WS_L) + (size_t)l * T * 4;
        const int nrep_ng = ((PROBE_REP_MASK >> ph) & 1u) ? 2 : 1;
#pragma nounroll
        for (int rpn = 0; rpn < nrep_ng; ++rpn)
        switch (ph) {
        case PH_P0: { is_gemm = false;
            { f32x4* z = (f32x4*)ws; float zf = 0.f; asm volatile("" : "+v"(zf)); const f32x4 zero = {zf, zf, zf, zf}; for (int i = bx * NTHR + tid; i < (int)(WS_ZERO_BYTES / 16); i += Gn * NTHR) z[i] = zero; }
            LAS float* scr = (LAS float*)(lds + wave * 8448);
#pragma nounroll
            for (int rq = 0; rq < ((PROBE_P0_PARTS & 1u) ? 2 : 1); ++rq)
            for (int it = gw; it < 30720; it += NGW) {
                int r = it, idx, K_ = 1024, N_ = 1024, typ; const float* src; const float* gain = nullptr;
                if (r < 2048) { idx = r >> 10; r &= 1023; src = INP(14) + (size_t)idx * 1024 * 2048; N_ = 2048; typ = 0; }
                else if ((r -= 2048) < 3072) { idx = r / 1536; r %= 1536; src = INP(15) + (size_t)idx * 1024 * 3072; N_ = 3072; typ = 1; gain = INP(3) + (size_t)(2 * idx + 1) * D; }
                else if ((r -= 3072) < 1024) { idx = r >> 9; r &= 511; src = INP(17) + (size_t)idx * 1024 * 1024; typ = 2; }
                else if ((r -= 1024) < 2048) { idx = r >> 9; r &= 511; src = INP(18) + (size_t)idx * 1024 * 1024; typ = 3; gain = INP(4) + (size_t)idx * D; }
                else if ((r -= 2048) < 4096) { idx = r >> 10; r &= 1023; src = INP(19) + (size_t)idx * 1024 * 2048; N_ = 2048; typ = 4; }
                else if ((r -= 4096) < 2048) { idx = r >> 9; r &= 511; src = INP(20) + (size_t)idx * 1024 * 1024; typ = 5; }
                else if ((r -= 2048) < 8192) { idx = r >> 11; r &= 2047; src = INP(21) + (size_t)idx * 1024 * 4096; N_ = 4096; typ = 6; gain = INP(5) + (size_t)idx * D; }
                else { r -= 8192; idx = r >> 11; r &= 2047; src = INP(22) + (size_t)idx * 4096 * 1024; K_ = 4096; typ = 7; }
                const int nblk = N_ / 32, kb = r / nblk, nb = r % nblk, k0 = 64 * kb, n0 = 32 * nb; bf16_t* dst;
                switch (typ) {
                case 0: { const int n1 = n0 & 1023, row = (n1 >> 7) * 256 + (n0 >= 1024 ? 128 : 0) + (n1 & 127); dst = (bf16_t*)(ws + WS_WGLU) + ((size_t)idx * 2048 + row) * 1024; } break;
                case 1: { int row; if (n0 < 1024) row = n0; else { const int n1 = (n0 - 1024) & 1023; row = 1024 + (n1 >> 7) * 256 + (n0 >= 2048 ? 128 : 0) + (n1 & 127); } dst = (bf16_t*)(ws + WS_WIN) + ((size_t)idx * 3072 + row) * 1024; } break;
                case 2: dst = (bf16_t*)(ws + WS_WOUT) + ((size_t)idx * 1024 + n0) * 1024; break;
                case 3: dst = (bf16_t*)(ws + WS_WQ) + ((size_t)idx * 1024 + n0) * 1024; break;
                case 4: dst = (n0 < 1024) ? (bf16_t*)(ws + WS_WK) + ((size_t)idx * 1024 + n0) * 1024 : (bf16_t*)(ws + WS_WV) + ((size_t)idx * 1024 + n0 - 1024) * 1024; break;
                case 5: dst = (bf16_t*)(ws + WS_WO) + ((size_t)idx * 1024 + n0) * 1024; break;
                case 6: dst = (bf16_t*)(ws + WS_W1) + ((size_t)idx * 4096 + n0) * 1024; break;
                default: dst = (bf16_t*)(ws + WS_W2) + ((size_t)idx * 1024 + n0) * 4096; break;
                }
                if (typ == 3) {
                    const f32x4* sp = (const f32x4*)(src + (size_t)r * 2048) + lane; u32x2* dp = (u32x2*)((bf16_t*)(ws + WS_WQ) + (size_t)idx * 1024 * 1024 + (size_t)r * 2048) + lane;
                    f32x4 wv[8];
#pragma unroll
                    for (int q = 0; q < 8; ++q) wv[q] = __builtin_nontemporal_load(sp + 64 * q);
                    const float g0 = gain[2 * r], g1 = gain[2 * r + 1];
#pragma unroll
                    for (int q = 0; q < 8; ++q) { const float gq = q < 4 ? g0 : g1; u32x2 w; w.x = pk2(wv[q][0] * gq, wv[q][1] * gq); w.y = pk2(wv[q][2] * gq, wv[q][3] * gq); dp[64 * q] = w; }
                    continue; }
                transpose_item(src, K_, N_, dst, k0, n0, gain, scr, lane);
            }
            for (int m = gw; m < BATCH * NMEM; m += NGW) { f32x4 v[4]; rms_row(INP(1) + (size_t)m * D, INP(2), lane, v); u32x2* o = (u32x2*)((bf16_t*)(ws + WS_MEMN) + (size_t)m * D) + lane;
#pragma unroll
                for (int jj = 0; jj < 4; ++jj) { u32x2 w; w.x = pk2(v[jj][0], v[jj][1]); w.y = pk2(v[jj][2], v[jj][3]); o[64 * jj] = w; } }
            __syncthreads();
#pragma nounroll
            for (int rq = 0; rq < ((PROBE_P0_PARTS & 2u) ? 2 : 1); ++rq)
            { const int skip = (Gn >= 128) ? SG : 0;
              for (int ci = bx - skip; ci >= 0 && ci < BATCH * NCH; ci += Gn - skip) norm_chunk_to_uext<false>(INP(0), INP(3), (bf16_t*)(big + BG_UEXT), ci, lds, wave, lane); }
            { SsmIn si{INP(6), INP(7), INP(8), INP(9), INP(10), INP(11), INP(12), ws}; for (int rq = 0; rq < ((PROBE_P0_PARTS & 4u) ? 2 : 1); ++rq) for (int g = bx; g < SG; g += Gn) build_ssm(si, 0, g, lds, tid); }
        } break;
        case PH_KVK: S.nM = BATCH * NMEM / 256; S.nN = 32; S.A = (const char*)(ws + WS_MEMN); S.B = (const char*)(ws + WS_WK); E.o0 = (bf16_t*)(ws + WS_KB); E.ldc = 8192; do_sync = false; break;
        case PH_KVV: is_gemm = false; do_sync = false; break;
        case PH_SSM1: S.nM = BATCH * SG; S.nN = 1; S.A = (const char*)(big + BG_UEXT); S.am = 256L * KX * 2; S.B = (const char*)(ws + WS_F); S.bn = 0; S.bg = 128L * 256 * 2; lda = KX; ldb = 256; K = 256;
            E.mode = pg8::M_G; E.f2 = (float*)(big + BG_G); local_seam = true; break;
        case PH_SCAN: is_gemm = false; local_seam = true; S.nM = BATCH * SG; S.nN = 1; S.nwg = S.nM; ssm_scan(ws, lds, S, wave, lane); break;
        case PH_SSM3: S.nM = BATCH * SG; S.nN = 1; S.A = (const char*)(big + BG_UEXT); S.am = 256L * KX * 2; S.B = (const char*)(ws + WS_W2X); S.bn = 0; S.bg = 256L * KX * 2; lda = KX; ldb = KX; K = KX;
            E.mode = pg8::M_Y; E.o0 = (bf16_t*)(big + BG_Y); E.b0 = (const bf16_t*)(big + BG_UEXT); E.f1 = INP(13) + (size_t)j * D; break;
        case PH_GLU: S.nN = 8; S.A = (const char*)(big + BG_Y); S.B = (const char*)(ws + WS_WGLU + (size_t)j * 2048 * 1024 * 2);
            E.mode = pg8::M_GLU; E.f0 = (l == 0) ? INP(0) : nullptr; E.o0 = XG; E.sout = SSb + (size_t)(l * 3 + 1) * T; do_sync = false; break;
        case PH_Q:
            S.nM = 32; S.nN = 4; S.A = (const char*)(ws + WS_KB + (size_t)l * 1024 * 2); S.ash = 2; S.am = 256L * 8192 * 2; S.amask = 3; S.am2 = 256 * 2;
            S.B = (const char*)(ws + WS_WQ + (size_t)l * 1024 * 1024 * 2); S.bn = 256L * 1024 * 2; S.bmask = 3; S.bg = 256 * 2; lda = 8192; ldb = 1024; K = 256;
            E.o0 = (bf16_t*)(big + BG_MB); E.ldc = 1024; do_sync = false; break;
        case PH_SP:
            S.nM = 32; S.nN = 4; S.c = (bx + Gn / 2) % Gn; S.A = (const char*)(ws + WS_WO + (size_t)l * 1024 * 1024 * 2); S.am = 0; S.amask = 3; S.am2 = 256 * 2; S.an = 256L * 1024 * 2;
            S.B = (const char*)(ws + WS_KB + (size_t)(4096 + l * 1024) * 2); S.bn = 0; S.bsh = 2; S.bb = 256L * 8192 * 2; S.bmask = 3; S.bg = 256 * 2; lda = 1024; ldb = 8192; K = 256;
            E.mode = pg8::M_STORE_N; E.o0 = (bf16_t*)(big + BG_NB); break;
        case PH_OV:
            S.A = (const char*)XG; S.B = (const char*)(big + BG_MB); S.bb = 1024L * 1024 * 2;
            E.mode = pg8::M_SOFT; E.o0 = (bf16_t*)(big + BG_P); E.sin = SSb + (size_t)(l * 3 + 1) * T; E.mul = 0.0625f * 1.4426950409f; break;
        case PH_WO:
            S.A = (const char*)(big + BG_P); S.B = (const char*)(big + BG_NB); S.bb = 1024L * 1024 * 2;
            E.mode = pg8::M_RES; E.o0 = XG; E.sout = SSb + (size_t)(l * 3 + 2) * T; break;
        case PH_UP: S.nN = 16; S.A = (const char*)XG; S.B = (const char*)(ws + WS_W1 + (size_t)l * 4096 * 1024 * 2);
            E.mode = pg8::M_UP; E.o0 = (bf16_t*)(big + BG_H); E.ldc = FF; E.sin = SSb + (size_t)(l * 3 + 2) * T; break;
        case PH_DOWN: S.A = (const char*)(big + BG_H); S.am = 256L * FF * 2; S.B = (const char*)(ws + WS_W2 + (size_t)l * 4096 * 1024 * 2); S.bn = 256L * FF * 2; lda = FF; ldb = FF; K = FF;
            E.mode = pg8::M_RES; E.o0 = XG;
            if ((l & 1) == 0) E.sout = SSb + (size_t)((l + 1) * 3) * T; break;
        case PH_CONVIN: S.nN = 12; S.A = (const char*)XG; S.B = (const char*)(ws + WS_WIN + (size_t)j * 3072 * 1024 * 2);
            E.mode = pg8::M_CONVIN; E.o0 = (bf16_t*)(big + BG_BC); E.o1 = (bf16_t*)(big + BG_Z); E.sin = SSb + (size_t)(l * 3) * T; break;
        case PH_CONV: { is_gemm = false;
            const bf16_t* Bc = (const bf16_t*)(big + BG_BC); const bf16_t* Z = (const bf16_t*)(big + BG_Z); bf16_t* Uc = (bf16_t*)(big + BG_UC); const float* cw = INP(16) + (size_t)j * 3 * D;
            for (int i = bx * NTHR + tid; i < T * 128; i += Gn * NTHR) { const int t = i >> 7, c8 = (i & 127) * 8, tl = t & (SEQ - 1); const size_t off = (size_t)t * D + c8;
                const u32x4 z0 = *(const u32x4*)(Z + off), bv = *(const u32x4*)(Bc + off); unsigned zu = 0u; asm volatile("" : "+v"(zu)); u32x4 z1 = {zu, zu, zu, zu}, z2 = {zu, zu, zu, zu};
                if (tl >= 1) z1 = *(const u32x4*)(Z + off - D); if (tl >= 2) z2 = *(const u32x4*)(Z + off - 2 * D);
                f32x4 o0, o1;
#pragma unroll
                for (int q = 0; q < 4; ++q) { const int cc = c8 + 2 * q;
                    const float w0a = cw[cc], w0b = cw[cc + 1], w1a = cw[D + cc], w1b = cw[D + cc + 1], w2a = cw[2 * D + cc], w2b = cw[2 * D + cc + 1];
                    const float ra = pg8::bf_lo(bv[q]) * (w0a * pg8::bf_lo(z2[q]) + w1a * pg8::bf_lo(z1[q]) + w2a * pg8::bf_lo(z0[q]));
                    const float rb = pg8::bf_hi(bv[q]) * (w0b * pg8::bf_hi(z2[q]) + w1b * pg8::bf_hi(z1[q]) + w2b * pg8::bf_hi(z0[q]));
                    if (q < 2) { o0[2 * q] = ra; o0[2 * q + 1] = rb; } else { o1[2 * (q - 2)] = ra; o1[2 * (q - 2) + 1] = rb; } }
                *(u32x4*)(Uc + off) = pg8::pack8(o0, o1); }
        } break;
        case PH_CONVOUT: S.A = (const char*)(big + BG_UC); S.B = (const char*)(ws + WS_WOUT + (size_t)j * 1024 * 1024 * 2);
            E.mode = pg8::M_RES; E.o0 = XG; E.sout = SSb + (size_t)(l * 3 + 1) * T; do_sync = false; break;
        case PH_NORM2: is_gemm = false;
            for (int ci = bx; ci < BATCH * NCH; ci += Gn) norm_chunk_to_uext<true>(XG, INP(3) + 2 * D, (bf16_t*)(big + BG_UEXT), ci, lds, wave, lane);
            { SsmIn si{INP(6), INP(7), INP(8), INP(9), INP(10), INP(11), INP(12), ws}; for (int g = bx; g < SG; g += Gn) build_ssm(si, 1, g, lds, tid); }
            break;
        default: is_gemm = false;
            for (int m = gw; m < T; m += NGW) { f32x4 v[4]; rms_row_bf(XG + (size_t)m * D, INP(23), lane, v); f32x4* o = (f32x4*)(xres + (size_t)m * D) + lane;
#pragma unroll
                for (int jj = 0; jj < 4; ++jj) o[64 * jj] = v[jj]; }
            do_sync = false; break;
        }
        S.nwg = S.nM * S.nN;
        if (is_gemm) { const int nrep = ((PROBE_REP_MASK >> ph) & 1u) ? 2 : 1;
#pragma nounroll
            for (int rp = 0; rp < nrep; ++rp) pg8::gemm_phase<pg8::Epi, pg8::Order, true, true>(lds, lda, ldb, K, S, E, tid); }
        if (do_sync) {
            if (local_seam) {
                asm volatile("s_waitcnt vmcnt(0)" ::: "memory"); __builtin_amdgcn_fence(__ATOMIC_ACQUIRE, "agent"); asm volatile("s_waitcnt vmcnt(0)" ::: "memory"); __syncthreads();
            } else if (xres == nullptr) {
                __builtin_amdgcn_fence(__ATOMIC_RELEASE, "agent"); asm volatile("s_waitcnt vmcnt(0)" ::: "memory");
                grid.sync();
                __builtin_amdgcn_fence(__ATOMIC_ACQUIRE, "agent"); asm volatile("s_waitcnt vmcnt(0)" ::: "memory");
            } else {
#pragma nounroll
                for (int sr = 0; sr < PROBE_SYNC_REP; ++sr) { unsigned* barp = (unsigned*)(ws + WS_BAR); XcdBarrier xb; xb.bar = barp; xb.x = xb_xcc_id(); xb.st = (volatile LAS unsigned*)(lds + 131072 + 64); xcd_barrier(xb); }
            }
        }
    }
}

extern "C" void kernel_launch(void* const* d_in, const int* in_sizes, int n_in, void* d_out, int out_size, void* d_ws, size_t ws_size, hipStream_t stream) {
    static int grid = 0;
    if (grid == 0) {
        if (n_in != 24 || out_size != T * D || ws_size < WS_END) { fprintf(stderr, "kernel_launch: unexpected shapes (n_in %d out %d ws %zu)\n", n_in, out_size, ws_size); grid = -1; return; }
        int dev = 0, cus = 0, per_cu = 0;
        (void)hipGetDevice(&dev); (void)hipDeviceGetAttribute(&cus, hipDeviceAttributeMultiprocessorCount, dev);
        if (hipFuncSetAttribute((const void*)mega_fwd, hipFuncAttributeMaxDynamicSharedMemorySize, LDS_BYTES) != hipSuccess) { fprintf(stderr, "kernel_launch: hipFuncSetAttribute failed\n"); grid = -1; return; }
        if (hipOccupancyMaxActiveBlocksPerMultiprocessor(&per_cu, (const void*)mega_fwd, NTHR, LDS_BYTES) != hipSuccess || per_cu < 1) { (void)hipGetLastError(); per_cu = 1; }
        grid = cus * per_cu;
        fprintf(stderr, "kernel_launch: %d CUs x %d blocks/CU\n", cus, per_cu);
    }
    if (grid < 0) return;
    if (hipMemsetAsync((char*)d_ws + WS_BAR, 0, XCD_BAR_WORDS * 4, stream) != hipSuccess) { fprintf(stderr, "kernel_launch: memset failed\n"); return; }
    Args a{};
    for (int i = 0; i < 24; ++i) a.in[i] = (const float*)d_in[i];
    a.out = (float*)d_out; a.ws = (unsigned char*)d_ws;
    void* kargs[] = {&a};
    hipError_t e = hipLaunchCooperativeKernel((const void*)mega_fwd, dim3(grid), dim3(NTHR), kargs, LDS_BYTES, stream);
    if (e != hipSuccess) fprintf(stderr, "kernel_launch: cooperative launch failed: %s (grid %d)\n", hipGetErrorString(e), grid);
}
```
